# Optimizing an MI355X kernel written in HIP

```python
import math
import jax, jax.numpy as jnp
from jax import lax
import numpy as np

D_MODEL = 1024
BATCH = 2
SEQ = 8192
DEPTH = 1
DEC_BATCH = 32
DEC_SEQ = 4
PAST_LEN = 8192
PAGE_SIZE = 128

N_HEADS_A = 8
HEAD_DIM_A = 64
WIDTH_A = N_HEADS_A * HEAD_DIM_A
N_HEADS_IDX = 4
HEAD_DIM_IDX = 64
TOPK_MAX = 256
Q_BLOCK = 128
N_HEADS_R = 8
DK_R = 64
DV_R = 64
WIDTH_R = N_HEADS_R * DV_R
CHUNK_R = 128
ROPE_BASE = 10000.0
EPS = 1e-6
IN_SIZES = (WIDTH_A, WIDTH_A, WIDTH_A, WIDTH_A,
            N_HEADS_IDX * HEAD_DIM_IDX, HEAD_DIM_IDX, N_HEADS_IDX,
            N_HEADS_R * DK_R, N_HEADS_R * DK_R, WIDTH_R, WIDTH_R,
            D_MODEL, D_MODEL)
N_IN = sum(IN_SIZES)

kernel_name = "dsa_retention_gated_hybrid_step"


def rms_norm(x, g):
    xf = x.astype(jnp.float32)
    r = lax.rsqrt(jnp.mean(xf * xf, axis=-1, keepdims=True) + EPS)
    return (xf * r).astype(x.dtype) * g


def modulated_input(x, c, w_ada, b_ada, g_norm):
    mod = jax.nn.silu(c) @ w_ada + b_ada
    shift, scale, gate = jnp.split(mod, 3, axis=-1)
    h = rms_norm(x, g_norm) * (1 + scale[:, None, :]) + shift[:, None, :]
    return h, gate


def split_projection(u):
    offs, o = [], 0
    for s in IN_SIZES[:-1]:
        o += s
        offs.append(o)
    return jnp.split(u, offs, axis=-1)


def rotary(x, pos):
    half = x.shape[-1] // 2
    inv = ROPE_BASE ** (-jnp.arange(half, dtype=jnp.float32) / half)
    ang = pos.astype(jnp.float32)[:, None] * inv[None, :]
    cos = jnp.cos(ang)[None, :, None, :]
    sin = jnp.sin(ang)[None, :, None, :]
    xf = x.astype(jnp.float32)
    x1, x2 = xf[..., :half], xf[..., half:]
    return jnp.concatenate([x1 * cos - x2 * sin, x1 * sin + x2 * cos], axis=-1)


def retention_log_decay():
    return jnp.log1p(-jnp.exp2(-5.0 - jnp.arange(N_HEADS_R, dtype=jnp.float32)))


def retention_chunk(state, q, k, v):
    C = q.shape[1]
    lg = retention_log_decay()
    i = jnp.arange(C, dtype=jnp.float32)
    diff = i[:, None] - i[None, :]
    dmat = jnp.where(diff >= 0, jnp.exp(lg[:, None, None] * jnp.maximum(diff, 0.0)), 0.0)
    scores = jnp.einsum('bihd,bjhd->bhij', q, k) * dmat
    out = jnp.einsum('bhij,bjhe->bihe', scores, v)
    q_decay = jnp.exp(lg[None, :] * (i[:, None] + 1.0))
    out = out + jnp.einsum('bihd,bhde->bihe', q, state) * q_decay[None, :, :, None]
    k_decay = jnp.exp(lg[None, :] * (C - 1.0 - i)[:, None])
    new_state = (jnp.exp(lg * C)[None, :, None, None] * state
                 + jnp.einsum('bjhd,bjhe->bhde', k * k_decay[None, :, :, None], v))
    return new_state, out


def retention_prompt(q, k, v):
    B, T = q.shape[:2]
    n = T // CHUNK_R
    chunks = lambda a: jnp.moveaxis(a.reshape(B, n, CHUNK_R, *a.shape[2:]), 1, 0)
    state0 = jnp.zeros((B, N_HEADS_R, DK_R, DV_R), jnp.float32)
    state, outs = lax.scan(lambda s, xs: retention_chunk(s, *xs), state0,
                           (chunks(q), chunks(k), chunks(v)))
    return jnp.moveaxis(outs, 0, 1).reshape(B, T, N_HEADS_R, DV_R), state


def group_norm_heads(o):
    mu = jnp.mean(o, axis=-1, keepdims=True)
    var = jnp.mean(jnp.square(o - mu), axis=-1, keepdims=True)
    y = (o - mu) * lax.rsqrt(var + EPS)
    return y.reshape(*o.shape[:2], -1)


def index_scores(qi, wi, ki):
    s = jnp.einsum('bqhd,bsd->bqhs', qi.astype(jnp.float32), ki.astype(jnp.float32))
    w = wi.astype(jnp.float32) * (N_HEADS_IDX ** -0.5 * HEAD_DIM_IDX ** -0.5)
    return jnp.einsum('bqhs,bqh->bqs', jax.nn.relu(s), w)


def select_keys(scores, q_pos, topk):
    S = scores.shape[-1]
    admissible = jnp.arange(S)[None, None, :] <= q_pos[None, :, None]
    _, idx = lax.top_k(jnp.where(admissible, scores, -jnp.inf), topk)
    valid = idx <= q_pos[None, :, None]
    return idx, valid


def sparse_attend(q, kg, vg, valid):
    logits = jnp.einsum('bqhd,bqkhd->bhqk', q.astype(jnp.float32), kg.astype(jnp.float32)) * HEAD_DIM_A ** -0.5
    logits = jnp.where(valid[:, None], logits, -jnp.inf)
    p = jax.nn.softmax(logits, axis=-1)
    return jnp.einsum('bhqk,bqkhd->bqhd', p, vg.astype(jnp.float32)).astype(q.dtype)


take_rows = jax.vmap(lambda a, i: a[i])


def dsa_prompt(q, k, v, qi, ki, wi):
    B, T = q.shape[:2]
    nb = T // Q_BLOCK
    topk = min(TOPK_MAX, T // 4)
    blocks = lambda a: jnp.moveaxis(a.reshape(B, nb, Q_BLOCK, *a.shape[2:]), 1, 0)

    def one_block(args):
        n, qb, qib, wib = args
        pos = n * Q_BLOCK + jnp.arange(Q_BLOCK)
        idx, valid = select_keys(index_scores(qib, wib, ki), pos, topk)
        return sparse_attend(qb, take_rows(k, idx), take_rows(v, idx), valid)

    out = lax.map(one_block, (jnp.arange(nb), blocks(q), blocks(qi), blocks(wi)))
    return jnp.moveaxis(out, 0, 1).reshape(B, T, WIDTH_A)


def dsa_sample(q, k_new, v_new, qi, ki_new, wi, cache_k, cache_v, cache_kidx, page_table):
    DB, T = q.shape[:2]
    topk = min(TOPK_MAX, (PAST_LEN + T) // 4)
    ki_past = cache_kidx[page_table].reshape(DB, PAST_LEN, HEAD_DIM_IDX)
    ki_all = jnp.concatenate([ki_past.astype(ki_new.dtype), ki_new], axis=1)
    pos = PAST_LEN + jnp.arange(T)
    idx, valid = select_keys(index_scores(qi, wi, ki_all), pos, topk)
    in_past = idx < PAST_LEN
    idx_p = jnp.minimum(idx, PAST_LEN - 1)
    phys = jnp.take_along_axis(page_table, (idx_p // PAGE_SIZE).reshape(DB, -1), axis=1).reshape(idx.shape)
    slot = idx_p % PAGE_SIZE
    idx_n = jnp.clip(idx - PAST_LEN, 0, T - 1)
    kg = jnp.where(in_past[..., None, None], cache_k[phys, slot].astype(k_new.dtype), take_rows(k_new, idx_n))
    vg = jnp.where(in_past[..., None, None], cache_v[phys, slot].astype(v_new.dtype), take_rows(v_new, idx_n))
    return sparse_attend(q, kg, vg, valid).reshape(DB, T, WIDTH_A)


def hybrid_layer(x, c, pos, attn_fn, ret_fn, w_ada, b_ada, g_norm, w_in, g_ret, w_pa, w_pr, w_out):
    B, T, _ = x.shape
    h, gate = modulated_input(x, c, w_ada, b_ada, g_norm)
    qa, ka, va, za, qi, ki, wi, qr, kr, vr, zr, ga, gr = split_projection(h @ w_in)
    heads = lambda a, n: a.reshape(B, T, n, -1)
    ka, va = heads(ka, N_HEADS_A), heads(va, N_HEADS_A)
    y_a = attn_fn(heads(qa, N_HEADS_A), ka, va, heads(qi, N_HEADS_IDX), ki, wi) * jax.nn.silu(za)
    q_r = rotary(heads(qr, N_HEADS_R), pos)
    k_r = rotary(heads(kr, N_HEADS_R), pos) * DK_R ** -0.5
    ret, ret_state = ret_fn(q_r, k_r, heads(vr, N_HEADS_R).astype(jnp.float32))
    y_r = group_norm_heads(ret).astype(x.dtype) * g_ret * jax.nn.silu(zr)
    merged = jax.nn.sigmoid(ga) * (y_a @ w_pa) + jax.nn.sigmoid(gr) * (y_r @ w_pr)
    x = x + gate[:, None, :] * (merged @ w_out)
    return x, (ka, va, ki, ret_state)


def setup_inputs(seed: int = 0) -> dict:
    key = jax.random.key(seed)
    ks = jax.random.split(key, 20)
    n_pages = PAST_LEN // PAGE_SIZE
    n_pool = (DEC_BATCH * n_pages * 5) // 4
    nrm = lambda k, shape, s=1.0: jax.random.normal(k, shape, jnp.float32) * s
    page_table = jax.random.permutation(ks[0], n_pool)[:DEC_BATCH * n_pages].reshape(DEC_BATCH, n_pages).astype(jnp.int32)
    return {
        "x_prompt": nrm(ks[1], (BATCH, SEQ, D_MODEL)),
        "x_sample": nrm(ks[2], (DEC_BATCH, DEC_SEQ, D_MODEL)),
        "cache_k": nrm(ks[3], (DEPTH, n_pool, PAGE_SIZE, N_HEADS_A, HEAD_DIM_A)),
        "cache_v": nrm(ks[4], (DEPTH, n_pool, PAGE_SIZE, N_HEADS_A, HEAD_DIM_A)),
        "cache_kidx": nrm(ks[5], (DEPTH, n_pool, PAGE_SIZE, HEAD_DIM_IDX)),
        "state_ret": nrm(ks[6], (DEPTH, DEC_BATCH, N_HEADS_R, DK_R, DV_R), 0.5),
        "page_table": page_table,
        "c_prompt": nrm(ks[7], (BATCH, D_MODEL)),
        "c_sample": nrm(ks[8], (DEC_BATCH, D_MODEL)),
        "w_ada": nrm(ks[9], (DEPTH, D_MODEL, 3 * D_MODEL), 0.2 * D_MODEL ** -0.5),
        "b_ada": nrm(ks[10], (DEPTH, 3 * D_MODEL), 0.01),
        "g_norm": 1.0 + nrm(ks[11], (DEPTH, D_MODEL), 0.02),
        "w_in": nrm(ks[12], (DEPTH, D_MODEL, N_IN), D_MODEL ** -0.5),
        "g_ret": 1.0 + nrm(ks[13], (DEPTH, WIDTH_R), 0.02),
        "w_pa": nrm(ks[14], (DEPTH, WIDTH_A, D_MODEL), WIDTH_A ** -0.5),
        "w_pr": nrm(ks[15], (DEPTH, WIDTH_R, D_MODEL), WIDTH_R ** -0.5),
        "w_out": nrm(ks[16], (DEPTH, D_MODEL, D_MODEL), D_MODEL ** -0.5),
        "g_final": 1.0 + nrm(ks[17], (D_MODEL,), 0.02),
    }


def reference(x_prompt, x_sample, cache_k, cache_v, cache_kidx, state_ret, page_table, c_prompt, c_sample,
              w_ada, b_ada, g_norm, w_in, g_ret, w_pa, w_pr, w_out, g_final):
    pos_p = jnp.arange(x_prompt.shape[1])
    pos_s = PAST_LEN + jnp.arange(x_sample.shape[1])
    hp, hs = x_prompt, x_sample
    kp, vp, kip, sp, kss, vss, kis, sss = [], [], [], [], [], [], [], []
    for l in range(DEPTH):
        lw = (w_ada[l], b_ada[l], g_norm[l], w_in[l], g_ret[l], w_pa[l], w_pr[l], w_out[l])
        hp, (k1, v1, ki1, s1) = hybrid_layer(hp, c_prompt, pos_p, dsa_prompt, retention_prompt, *lw)
        ck, cv, cki, st = cache_k[l], cache_v[l], cache_kidx[l], state_ret[l].astype(jnp.float32)
        attn_s = lambda q, k, v, qi, ki, wi: dsa_sample(q, k, v, qi, ki, wi, ck, cv, cki, page_table)
        def ret_s(q, k, v):
            new_state, out = retention_chunk(st, q, k, v)
            return out, new_state
        hs, (k2, v2, ki2, s2) = hybrid_layer(hs, c_sample, pos_s, attn_s, ret_s, *lw)
        kp.append(k1); vp.append(v1); kip.append(ki1); sp.append(s1)
        kss.append(k2); vss.append(v2); kis.append(ki2); sss.append(s2)
    y_prompt = rms_norm(hp, g_final)
    y_sample = rms_norm(hs, g_final)
    return (y_prompt, y_sample, jnp.stack(kp), jnp.stack(vp), jnp.stack(kip), jnp.stack(sp),
            jnp.stack(kss), jnp.stack(vss), jnp.stack(kis), jnp.stack(sss))
```

```cpp
#include <hip/hip_runtime.h>
#include <hip/hip_bf16.h>
#include <cstdio>
#include <cstdint>
#include <cmath>
constexpr int D = 1024, SEQ = 8192, NB = 2, DB = 32, DSEQ = 4, PAST = 8192, PAGE = 128, NPAGES = PAST / PAGE;
constexpr int MP = NB * SEQ;
constexpr int MS = DB * DSEQ;
constexpr int MR = MP + MS;
constexpr int MT = 16640;
constexpr int NH = 8, HD = 64, WA = 512, NHI = 4, HDI = 64, TOPK = 256;
constexpr int NIN = 6468, NINP = 6656;
constexpr int NMOD = 2 + DB;
constexpr float EPS = 1e-6f;
constexpr size_t O_YP = 0, O_YS = O_YP + (size_t)MP * D, O_KP = O_YS + (size_t)MS * D, O_VP = O_KP + (size_t)MP * WA, O_KIP = O_VP + (size_t)MP * WA,
                 O_RSP = O_KIP + (size_t)MP * HDI, O_KS = O_RSP + (size_t)NB * NH * 64 * 64, O_VS = O_KS + (size_t)MS * WA, O_KIS = O_VS + (size_t)MS * WA,
                 O_RSS = O_KIS + (size_t)MS * HDI, O_END = O_RSS + (size_t)DB * NH * 64 * 64;
static_assert(O_END == 35987456, "output size");
namespace pg8 {
#define PG8_LAS __attribute__((address_space(3)))
typedef unsigned short bf16_t;
typedef short bf16x8 __attribute__((ext_vector_type(8)));
typedef float f32x4 __attribute__((ext_vector_type(4)));
typedef unsigned u32x4 __attribute__((ext_vector_type(4)));
constexpr int BM = 256, BK = 64, HALF = 128, HTB = HALF * BK * 2  , STAGE_BYTES = 8 * HTB, NXCD = 8, WGM = 8;

__host__ __device__ __forceinline__ int lds_byte(int r, int c) { const int st = (r >> 4) * 2 + (c >> 5), rr = r & 15, cc = c & 31, ob = rr * 64 + cc * 2; return st * 1024 + (ob ^ (((ob >> 9) & 1) << 5)); }
__host__ __device__ __forceinline__ void stage_rc(int b, int& R, int& C) { const int st = b / 1024, sb = b % 1024, swz = sb ^ (((sb >> 9) & 1) << 5); R = (st >> 1) * 16 + swz / 64; C = (st & 1) * 32 + (swz % 64) / 2; }
__host__ __device__ __forceinline__ int perm32(int rho) { const int n = rho >> 4, i = rho & 15; return 8 * (i >> 2) + 4 * n + (i & 3); }

struct Unit { int pm, pn; };
struct Gemm { const bf16_t* A; const bf16_t* Bt; int M, N, K; };

struct StaticOrder {
    int nM, nN, nwg, G, c;
    __host__ __device__ void init(int M, int N, int G_, int c_) { nM = M / BM; nN = N / BM; nwg = nM * nN; G = G_; c = c_; }
    __host__ __device__ bool next(int i, Unit& u) const {
        const long L = (long)i * G + c; if (L >= nwg) return false;
        int wgid = (int)L; { const int q = nwg / NXCD, r = nwg % NXCD, xcd = wgid % NXCD, off = wgid / NXCD; wgid = (xcd < r ? xcd * (q + 1) : r * (q + 1) + (xcd - r) * q) + off; }
        const int nig = WGM * nN, gid = wgid / nig, fm = gid * WGM, gsz = (nM - fm) < WGM ? (nM - fm) : WGM;
        u.pm = fm + ((wgid % nig) % gsz); u.pn = (wgid % nig) / gsz; return true;
    }
    __device__ __forceinline__ void a_ready(const Unit&) const {}
    __device__ __forceinline__ void done(const Unit&) const {}
};

__device__ __forceinline__ unsigned cvt_pk_bf16(float lo, float hi) { unsigned r; asm volatile("v_cvt_pk_bf16_f32 %0, %1, %2" : "=v"(r) : "v"(lo), "v"(hi)); return r; }
__device__ __forceinline__ float bf_lo(unsigned w) { return __uint_as_float(w << 16); }
__device__ __forceinline__ float bf_hi(unsigned w) { return __uint_as_float(w & 0xffff0000u); }
__device__ __forceinline__ float sigmoidf_(float x) { return __builtin_amdgcn_rcpf(1.0f + __builtin_amdgcn_exp2f(-1.4426950408889634f * x)); }
__device__ __forceinline__ u32x4 pack8(f32x4 a, f32x4 b) { u32x4 w; w.x = cvt_pk_bf16(a[0], a[1]); w.y = cvt_pk_bf16(a[2], a[3]); w.z = cvt_pk_bf16(b[0], b[1]); w.w = cvt_pk_bf16(b[2], b[3]); return w; }

struct EpiIn {
    static constexpr bool PERM = true, AFTER_DRAIN = false;
    bf16_t *QA, *KA, *VA, *SZA, *QI, *KI, *QR, *KR, *VR, *SZR, *SGA, *SGR; float* WI; const float* rope; float* out;
    __device__ __forceinline__ void operator()(const f32x4 (&acc)[2][2][4][2], const Unit& u, int wr, int wc, int fr, int fq) const {
        const int pn = u.pn;
        const int rbase = u.pm * BM + wr * 64 + fr;
        const int cl = wc * 32 + 8 * fq;
        const bool smp = (u.pm == MP / BM);
        constexpr float C2 = 0.125f * 1.4426950408889634f;
        if (pn < 8) {
            const int seg = pn >> 1, c0 = (pn & 1) * 256 + cl;
            bf16_t* dst = seg == 0 ? QA : seg == 1 ? KA : seg == 2 ? VA : SZA;
            float* of = nullptr; if (seg == 1) of = out + (smp ? O_KS : O_KP); else if (seg == 2) of = out + (smp ? O_VS : O_VP);
#pragma unroll
            for (int ai = 0; ai < 2; ++ai)
#pragma unroll
                for (int m = 0; m < 4; ++m) { const int row = rbase + ai * HALF + m * 16;
#pragma unroll
                    for (int bj = 0; bj < 2; ++bj) { f32x4 v0 = acc[ai][bj][m][0], v1 = acc[ai][bj][m][1]; const int col = c0 + bj * HALF;
                        if (of && !(smp && ai == 1)) { float* o = of + (size_t)(smp ? row - MP : row) * WA + col; *(f32x4*)o = v0; *(f32x4*)(o + 4) = v1; }
                        if (seg == 0) { v0 = v0 * C2; v1 = v1 * C2; }
                        if (seg == 3) {
#pragma unroll
                            for (int e = 0; e < 4; ++e) { v0[e] = v0[e] * sigmoidf_(v0[e]); v1[e] = v1[e] * sigmoidf_(v1[e]); } }
                        *(u32x4*)(dst + (size_t)row * WA + col) = pack8(v0, v1); } }
        } else if (pn == 8) {
#pragma unroll
            for (int ai = 0; ai < 2; ++ai)
#pragma unroll
                for (int m = 0; m < 4; ++m) { const int row = rbase + ai * HALF + m * 16;
#pragma unroll
                    for (int bj = 0; bj < 2; ++bj) *(u32x4*)(QI + (size_t)row * 256 + bj * HALF + cl) = pack8(acc[ai][bj][m][0], acc[ai][bj][m][1]); }
        } else if (pn == 9) {
            if (wc < 2) {
                float* of = out + (smp ? O_KIS : O_KIP);
#pragma unroll
                for (int ai = 0; ai < 2; ++ai)
#pragma unroll
                    for (int m = 0; m < 4; ++m) { const int row = rbase + ai * HALF + m * 16; const f32x4 v0 = acc[ai][0][m][0], v1 = acc[ai][0][m][1];
                        if (!(smp && ai == 1)) { float* o = of + (size_t)(smp ? row - MP : row) * HDI + cl; *(f32x4*)o = v0; *(f32x4*)(o + 4) = v1; }
                        *(u32x4*)(KI + (size_t)row * HDI + cl) = pack8(v0, v1); }
            } else if (wc == 2 && fq == 0) {
#pragma unroll
                for (int ai = 0; ai < 2; ++ai)
#pragma unroll
                    for (int m = 0; m < 4; ++m) { const int row = rbase + ai * HALF + m * 16; *(f32x4*)(WI + (size_t)row * 4) = acc[ai][0][m][0] * 0.0625f; }
            }
        } else if (pn < 14) {
            const int seg = (pn - 10) >> 1, head = 4 * ((pn - 10) & 1) + wc; bf16_t* dst = seg == 0 ? QR : KR; const float sc = seg == 0 ? 1.0f : 0.125f;
#pragma unroll
            for (int ai = 0; ai < 2; ++ai)
#pragma unroll
                for (int m = 0; m < 4; ++m) { const int row = rbase + ai * HALF + m * 16; const int pos = smp ? PAST + ((row - MP) & 3) : (row & (SEQ - 1));
                    const f32x4* rp = (const f32x4*)(rope + ((size_t)pos * 32 + 8 * fq) * 2);
                    f32x4 o1[2], o2[2];
#pragma unroll
                    for (int n = 0; n < 2; ++n) { const f32x4 ca = rp[2 * n], cb = rp[2 * n + 1]; const f32x4 x1 = acc[ai][0][m][n], x2 = acc[ai][1][m][n];
                        o1[n][0] = (x1[0] * ca[0] - x2[0] * ca[1]) * sc; o2[n][0] = (x1[0] * ca[1] + x2[0] * ca[0]) * sc;
                        o1[n][1] = (x1[1] * ca[2] - x2[1] * ca[3]) * sc; o2[n][1] = (x1[1] * ca[3] + x2[1] * ca[2]) * sc;
                        o1[n][2] = (x1[2] * cb[0] - x2[2] * cb[1]) * sc; o2[n][2] = (x1[2] * cb[1] + x2[2] * cb[0]) * sc;
                        o1[n][3] = (x1[3] * cb[2] - x2[3] * cb[3]) * sc; o2[n][3] = (x1[3] * cb[3] + x2[3] * cb[2]) * sc; }
                    bf16_t* d = dst + (size_t)row * WA + head * 64 + 8 * fq;
                    *(u32x4*)d = pack8(o1[0], o1[1]); *(u32x4*)(d + 32) = pack8(o2[0], o2[1]); }
        } else if (pn < 18) {
            const int seg = (pn - 14) >> 1, c0 = ((pn - 14) & 1) * 256 + cl; bf16_t* dst = seg == 0 ? VR : SZR;
#pragma unroll
            for (int ai = 0; ai < 2; ++ai)
#pragma unroll
                for (int m = 0; m < 4; ++m) { const int row = rbase + ai * HALF + m * 16;
#pragma unroll
                    for (int bj = 0; bj < 2; ++bj) { f32x4 v0 = acc[ai][bj][m][0], v1 = acc[ai][bj][m][1];
                        if (seg == 1) {
#pragma unroll
                            for (int e = 0; e < 4; ++e) { v0[e] = v0[e] * sigmoidf_(v0[e]); v1[e] = v1[e] * sigmoidf_(v1[e]); } }
                        *(u32x4*)(dst + (size_t)row * WA + c0 + bj * HALF) = pack8(v0, v1); } }
        } else {
            const int col = 128 * (pn - 18) + cl;
#pragma unroll
            for (int ai = 0; ai < 2; ++ai)
#pragma unroll
                for (int m = 0; m < 4; ++m) { const int row = rbase + ai * HALF + m * 16;
#pragma unroll
                    for (int bj = 0; bj < 2; ++bj) { f32x4 v0 = acc[ai][bj][m][0], v1 = acc[ai][bj][m][1];
#pragma unroll
                        for (int e = 0; e < 4; ++e) { v0[e] = sigmoidf_(v0[e]); v1[e] = sigmoidf_(v1[e]); }
                        *(u32x4*)((bj == 0 ? SGA : SGR) + (size_t)row * D + col) = pack8(v0, v1); } }
        }
    }
};
template <int MODE> struct EpiGate {
    static constexpr bool PERM = true, AFTER_DRAIN = false;
    const bf16_t* G; const bf16_t* T1in; bf16_t* O;
    __device__ __forceinline__ void operator()(const f32x4 (&acc)[2][2][4][2], const Unit& u, int wr, int wc, int fr, int fq) const {
        const int rbase = u.pm * BM + wr * 64 + fr, c0 = u.pn * BM + wc * 32 + 8 * fq;
#pragma unroll
        for (int ai = 0; ai < 2; ++ai)
#pragma unroll
            for (int m = 0; m < 4; ++m) { const size_t ro = (size_t)(rbase + ai * HALF + m * 16) * D;
#pragma unroll
                for (int bj = 0; bj < 2; ++bj) { const size_t off = ro + c0 + bj * HALF; const u32x4 g = *(const u32x4*)(G + off);
                    f32x4 v0 = acc[ai][bj][m][0], v1 = acc[ai][bj][m][1];
                    v0[0] *= bf_lo(g.x); v0[1] *= bf_hi(g.x); v0[2] *= bf_lo(g.y); v0[3] *= bf_hi(g.y); v1[0] *= bf_lo(g.z); v1[1] *= bf_hi(g.z); v1[2] *= bf_lo(g.w); v1[3] *= bf_hi(g.w);
                    if (MODE == 1) { const u32x4 t = *(const u32x4*)(T1in + off);
                        v0[0] += bf_lo(t.x); v0[1] += bf_hi(t.x); v0[2] += bf_lo(t.y); v0[3] += bf_hi(t.y); v1[0] += bf_lo(t.z); v1[1] += bf_hi(t.z); v1[2] += bf_lo(t.w); v1[3] += bf_hi(t.w); }
                    *(u32x4*)(O + off) = pack8(v0, v1); } }
    }
};
struct EpiOut {
    static constexpr bool PERM = false, AFTER_DRAIN = false;
    const float* xp; const float* xs; const float* mod; const float* bada; float* y;
    __device__ __forceinline__ void operator()(const f32x4 (&acc)[2][2][4][2], const Unit& u, int wr, int wc, int fr, int fq) const {
        const int rbase = u.pm * BM + wr * 64 + fr, c0 = u.pn * BM + wc * 32 + 4 * fq;
#pragma unroll
        for (int ai = 0; ai < 2; ++ai)
#pragma unroll
            for (int m = 0; m < 4; ++m) { const int row = rbase + ai * HALF + m * 16; if (row >= MR) continue;
                const float* xr = row < MP ? xp + (size_t)row * D : xs + (size_t)(row - MP) * D; const int mr = row < MP ? row / SEQ : 2 + ((row - MP) >> 2);
                const float* gr = mod + (size_t)mr * 3 * D + 2 * D; const float* br = bada + 2 * D; float* yr = y + (size_t)row * D;
#pragma unroll
                for (int bj = 0; bj < 2; ++bj)
#pragma unroll
                    for (int n = 0; n < 2; ++n) { const int col = c0 + bj * HALF + n * 16; const f32x4 g = *(const f32x4*)(gr + col) + *(const f32x4*)(br + col);
                        *(f32x4*)(yr + col) = *(const f32x4*)(xr + col) + g * acc[ai][bj][m][n]; } }
    }
};
template <class Epi, class Sched, bool ALIGN_EPI = false, bool SP2 = false>
__device__ __forceinline__ void gemm_phase(PG8_LAS unsigned char* lds, const Gemm g, const Sched& S, const Epi& E) {
    const int tid = threadIdx.x, wid = __builtin_amdgcn_readfirstlane(tid >> 6), lane = tid & 63, wr = wid >> 2, wc = wid & 3, fr = lane & 15, fq = lane >> 4;
    const int K = g.K, nt = K / BK;
    unsigned voffA[2], voffB[2];
#pragma unroll
    for (int i = 0; i < 2; ++i) { int R, C; stage_rc(tid * 16 + i * 8192, R, C); const int Rb = Epi::PERM ? ((R & ~31) + perm32(R & 31)) : R;
        voffA[i] = (unsigned)(R * K + C) * 2u; voffB[i] = (unsigned)(Rb * K + C) * 2u; }
    const size_t kstep = (size_t)(BK * 2);
    const size_t hstep = (size_t)HALF * K * 2;
    const size_t tstep = 2 * hstep;
    const unsigned ldsw = (unsigned)wid * 1024u;
    const int aoff = lds_byte(wr * 64 + fr, fq * 8), boff = lds_byte(wc * 32 + fr, fq * 8);
#define PG8_SA(b, h) (((b) * 2 + (h)) * HTB)
#define PG8_SB(b, h) ((4 + (b) * 2 + (h)) * HTB)
#define PG8_STAGE(bufoff, gbase, voff) do { _Pragma("unroll") for (int _i = 0; _i < 2; ++_i) \
        __builtin_amdgcn_global_load_lds((const unsigned*)((const char*)(gbase) + (voff)[_i]), (PG8_LAS unsigned*)(lds + (bufoff) + ldsw + _i * 8192), 16, 0, 0); } while (0)
#define PG8_LDA(dst, b, h) do { _Pragma("unroll") for (int m = 0; m < 4; ++m) _Pragma("unroll") for (int k = 0; k < 2; ++k) dst[m][k] = *(const PG8_LAS bf16x8*)(lds + PG8_SA(b, h) + aoff + m * 2048 + k * 1024); } while (0)
#define PG8_LDB(dst, b, h) do { _Pragma("unroll") for (int n = 0; n < 2; ++n) _Pragma("unroll") for (int k = 0; k < 2; ++k) dst[n][k] = *(const PG8_LAS bf16x8*)(lds + PG8_SB(b, h) + boff + n * 2048 + k * 1024); } while (0)
#define PG8_MMA(ai, bj, At, Bt) do { __builtin_amdgcn_s_setprio(1); _Pragma("unroll") for (int m = 0; m < 4; ++m) _Pragma("unroll") for (int n = 0; n < 2; ++n) _Pragma("unroll") for (int k = 0; k < 2; ++k) \
        acc[ai][bj][m][n] = __builtin_amdgcn_mfma_f32_16x16x32_bf16(Bt[n][k], At[m][k], acc[ai][bj][m][n], 0, 0, 0); __builtin_amdgcn_s_setprio(0); } while (0)
#define PG8_WAIT_V(n) asm volatile("s_waitcnt vmcnt(" #n ")" ::: "memory")
#define PG8_WAIT_L(n) asm volatile("s_waitcnt lgkmcnt(" #n ")" ::: "memory")
#define PG8_BAR __builtin_amdgcn_s_barrier()
#define PG8_SCHED __builtin_amdgcn_sched_barrier(0)
    Unit cur, nxt; int ui = 0;
    if (!S.next(0, cur)) return;
    f32x4 acc[2][2][4][2];
#pragma unroll
    for (int a = 0; a < 2; ++a)
#pragma unroll
        for (int b = 0; b < 2; ++b)
#pragma unroll
            for (int m = 0; m < 4; ++m)
#pragma unroll
                for (int n = 0; n < 2; ++n) acc[a][b][m][n] = (f32x4){0.f, 0.f, 0.f, 0.f};
    bf16x8 At[4][2], B0[2][2], B1[2][2];
    const char* cA = (const char*)g.A + (size_t)cur.pm * tstep; const char* cB = (const char*)g.Bt + (size_t)cur.pn * tstep;
    S.a_ready(cur);
    if constexpr (SP2) {
        PG8_STAGE(PG8_SB(0, 0), cB, voffB); PG8_STAGE(PG8_SB(0, 1), cB + hstep, voffB); PG8_STAGE(PG8_SA(0, 0), cA, voffA); PG8_STAGE(PG8_SA(0, 1), cA + hstep, voffA);
        if (wr == 1) PG8_BAR;
        PG8_WAIT_V(2); PG8_BAR;
        PG8_STAGE(PG8_SB(1, 0), cB + kstep, voffB); PG8_STAGE(PG8_SA(1, 0), cA + kstep, voffA); PG8_STAGE(PG8_SB(1, 1), cB + hstep + kstep, voffB);
        PG8_WAIT_V(6); PG8_BAR;
    } else {
        PG8_STAGE(PG8_SB(0, 0), cB, voffB); PG8_STAGE(PG8_SA(0, 0), cA, voffA); PG8_STAGE(PG8_SB(0, 1), cB + hstep, voffB); PG8_STAGE(PG8_SA(0, 1), cA + hstep, voffA);
        if (wr == 1) PG8_BAR;
        PG8_WAIT_V(4); PG8_BAR;
        PG8_STAGE(PG8_SB(1, 0), cB + kstep, voffB); PG8_STAGE(PG8_SA(1, 0), cA + kstep, voffA); PG8_STAGE(PG8_SB(1, 1), cB + hstep + kstep, voffB);
        PG8_WAIT_V(6); PG8_BAR;
    }
    for (;;) {
        const bool has_next = S.next(ui + 1, nxt);
        const char* nA = has_next ? (const char*)g.A + (size_t)nxt.pm * tstep : cA; const char* nB = has_next ? (const char*)g.Bt + (size_t)nxt.pn * tstep : cB;
        for (int t = 0; t < nt; t += 2) {
            const bool last = (t == nt - 2);
            const char* a1 = cA + (size_t)(t + 1) * kstep;
            const char* a2 = last ? nA : cA + (size_t)(t + 2) * kstep; const char* b2 = last ? nB : cB + (size_t)(t + 2) * kstep;
            const char* a3 = a2 + kstep; const char* b3 = b2 + kstep;
            if (last && has_next) S.a_ready(nxt);
            if constexpr (SP2) {
            PG8_LDB(B0, 0, 0); PG8_LDB(B1, 0, 1); PG8_SCHED; PG8_LDA(At, 0, 0); PG8_STAGE(PG8_SA(1, 1), a1 + hstep, voffA);
            PG8_WAIT_V(8); PG8_WAIT_L(0); PG8_BAR; PG8_MMA(0, 0, At, B0); PG8_MMA(0, 1, At, B1); PG8_BAR; PG8_SCHED;
            PG8_LDA(At, 0, 1); PG8_STAGE(PG8_SB(0, 0), b2, voffB); PG8_STAGE(PG8_SB(0, 1), b2 + hstep, voffB); PG8_STAGE(PG8_SA(0, 0), a2, voffA);
            PG8_WAIT_V(8); PG8_WAIT_L(0); PG8_BAR; PG8_MMA(1, 0, At, B0); PG8_MMA(1, 1, At, B1); PG8_BAR; PG8_SCHED;
            PG8_LDB(B0, 1, 0); PG8_LDB(B1, 1, 1); PG8_SCHED; PG8_LDA(At, 1, 0); PG8_STAGE(PG8_SA(0, 1), a2 + hstep, voffA);
            PG8_WAIT_V(8); PG8_WAIT_L(0); PG8_BAR; PG8_MMA(0, 0, At, B0); PG8_MMA(0, 1, At, B1); PG8_BAR; PG8_SCHED;
            PG8_LDA(At, 1, 1); PG8_STAGE(PG8_SB(1, 0), b3, voffB); PG8_STAGE(PG8_SB(1, 1), b3 + hstep, voffB); PG8_STAGE(PG8_SA(1, 0), a3, voffA);
            PG8_WAIT_V(8); PG8_WAIT_L(0); PG8_BAR; PG8_MMA(1, 0, At, B0); PG8_MMA(1, 1, At, B1); PG8_BAR; PG8_SCHED;
            } else {
            PG8_LDB(B0, 0, 0); PG8_SCHED; PG8_LDA(At, 0, 0); PG8_STAGE(PG8_SA(1, 1), a1 + hstep, voffA);
            PG8_WAIT_L(8); PG8_BAR; PG8_WAIT_L(0); PG8_MMA(0, 0, At, B0); PG8_BAR; PG8_SCHED;
            PG8_LDB(B1, 0, 1); PG8_STAGE(PG8_SB(0, 0), b2, voffB);
            PG8_BAR; PG8_WAIT_L(0); PG8_MMA(0, 1, At, B1); PG8_BAR;
            PG8_LDA(At, 0, 1); PG8_STAGE(PG8_SA(0, 0), a2, voffA);
            PG8_BAR; PG8_WAIT_L(0); PG8_MMA(1, 0, At, B0); PG8_BAR; PG8_SCHED;
            PG8_STAGE(PG8_SB(0, 1), b2 + hstep, voffB);
            PG8_WAIT_V(6); PG8_BAR; PG8_MMA(1, 1, At, B1); PG8_BAR;
            PG8_LDB(B0, 1, 0); PG8_SCHED; PG8_LDA(At, 1, 0); PG8_STAGE(PG8_SA(0, 1), a2 + hstep, voffA);
            PG8_WAIT_L(8); PG8_BAR; PG8_WAIT_L(0); PG8_MMA(0, 0, At, B0); PG8_BAR; PG8_SCHED;
            PG8_LDB(B1, 1, 1); PG8_STAGE(PG8_SB(1, 0), b3, voffB);
            PG8_BAR; PG8_WAIT_L(0); PG8_MMA(0, 1, At, B1); PG8_BAR;
            PG8_LDA(At, 1, 1); PG8_STAGE(PG8_SA(1, 0), a3, voffA);
            PG8_BAR; PG8_WAIT_L(0); PG8_MMA(1, 0, At, B0); PG8_BAR; PG8_SCHED;
            PG8_STAGE(PG8_SB(1, 1), b3 + hstep, voffB);
            PG8_WAIT_V(6); PG8_BAR; PG8_MMA(1, 1, At, B1); PG8_BAR;
            }
        }
        if constexpr (ALIGN_EPI) { if (wr == 0) PG8_BAR; }
        if constexpr (!Epi::AFTER_DRAIN) { E(acc, cur, wr, wc, fr, fq); S.done(cur); }
        if (!has_next) break;
#pragma unroll
        for (int a = 0; a < 2; ++a)
#pragma unroll
            for (int b = 0; b < 2; ++b)
#pragma unroll
                for (int m = 0; m < 4; ++m)
#pragma unroll
                    for (int n = 0; n < 2; ++n) acc[a][b][m][n] = (f32x4){0.f, 0.f, 0.f, 0.f};
        cur = nxt; cA = nA; cB = nB; ++ui;
        if constexpr (ALIGN_EPI) { if (wr == 1) PG8_BAR; }
    }
    PG8_WAIT_V(0);
    if constexpr (!ALIGN_EPI) { if (wr == 0) PG8_BAR; }
    PG8_BAR;
    if constexpr (Epi::AFTER_DRAIN) { E.fused(acc, cur, wr, wc, fr, fq, lds, wid, lane); S.done(cur); }
#undef PG8_SA
#undef PG8_SB
#undef PG8_STAGE
#undef PG8_LDA
#undef PG8_LDB
#undef PG8_MMA
#undef PG8_WAIT_V
#undef PG8_WAIT_L
#undef PG8_BAR
#undef PG8_SCHED
}
}
#include <hip/hip_bf16.h>
#include <cmath>
namespace attn_body {
using bf16=__hip_bfloat16;
using bf16x8=__attribute__((ext_vector_type(8)))short;
using s16x4=__attribute__((ext_vector_type(4)))short;
using f32x16=__attribute__((ext_vector_type(16)))float;
using u32x4=__attribute__((ext_vector_type(4)))unsigned;
constexpr int BATCH=2,NHEAD=8,SEQ=8192,D=64,DM=NHEAD*D;
constexpr int NW=8,QBLK=32,QB=QBLK*NW,KVBLK=64,NQB=SEQ/QB;
constexpr int ATTN_PITCH=DM, ATTN_UNIT_ROWS=QB;
__device__ __forceinline__ int crow(int r,int hi){return (r&3)+8*(r>>2)+4*hi;}
#define SBAR() __builtin_amdgcn_sched_barrier(0)
__device__ __forceinline__ void cmask(f32x16&p0,f32x16&p1,int jb,int qrel,int hi){
  const float NEG=-INFINITY; int kb=64*jb+4*hi;
  #pragma unroll
  for(int r=0;r<16;++r){int kv=kb+(r&3)+8*(r>>2); if(kv>qrel)p0[r]=NEG; if(kv+32>qrel)p1[r]=NEG;}
}

constexpr int NSLOT=3, SLOTB=8192;
constexpr int LDS_K=0, LDS_V=NSLOT*SLOTB, LDS_WS=2*NSLOT*SLOTB, LDS_OST=LDS_WS+NW*64*4, LDS_M=LDS_OST+NW*4096, LDS_BYTES=LDS_M+NW*768;
constexpr float C2=0.125f*1.4426950408889634f;
__device__ __forceinline__ void glds16(const void*gsrc,unsigned lds_dst){unsigned keep;
  asm volatile("s_mov_b32 %0, m0\n\ts_mov_b32 m0, %2\n\ts_nop 0\n\tglobal_load_lds_dwordx4 %1, off\n\ts_mov_b32 m0, %0":"=&s"(keep):"v"(gsrc),"s"(lds_dst):"memory");}
__device__ __forceinline__ void glds4(const void*gsrc,unsigned lds_dst){unsigned keep;
  asm volatile("s_mov_b32 %0, m0\n\ts_mov_b32 m0, %2\n\ts_nop 0\n\tglobal_load_lds_dword %1, off\n\ts_mov_b32 m0, %0":"=&s"(keep):"v"(gsrc),"s"(lds_dst):"memory");}
__device__ __forceinline__ void kmask(f32x16&p0,f32x16&p1,unsigned long long mw,int hi,float nm){
  const unsigned lo=(unsigned)mw>>(4*hi), hw=(unsigned)(mw>>32)>>(4*hi);
  #pragma unroll
  for(int r=0;r<16;++r){ const int c=(r&3)+8*(r>>2);
    const unsigned m0=(unsigned)((int)(lo<<(31-c))>>31), m1=(unsigned)((int)(hw<<(31-c))>>31);
    p0[r]=__uint_as_float((__float_as_uint(p0[r]+nm)&m0)|(0xff800000u&~m0));
    p1[r]=__uint_as_float((__float_as_uint(p1[r]+nm)&m1)|(0xff800000u&~m1)); }
}
__device__ __forceinline__ float max3f(float a,float b,float c){float r;asm("v_max3_f32 %0, %1, %2, %3":"=v"(r):"v"(a),"v"(b),"v"(c));return r;}
__device__ __forceinline__ float max2f(float a,float b){float r;asm("v_max_f32_e32 %0, %1, %2":"=v"(r):"v"(a),"v"(b));return r;}
__device__ __forceinline__ float fadd_s(float a,float b){float r;asm("v_add_f32_e32 %0, %1, %2":"=v"(r):"v"(a),"v"(b));return r;}
__device__ __forceinline__ float fsub_s(float a,float b){float r;asm("v_sub_f32_e32 %0, %1, %2":"=v"(r):"v"(a),"v"(b));return r;}
typedef float f32x2_t __attribute__((ext_vector_type(2))); typedef __bf16 bf16x2_t __attribute__((ext_vector_type(2)));
__device__ __forceinline__ unsigned cvtpk_s(float lo,float hi){f32x2_t v={lo,hi};bf16x2_t b=__builtin_convertvector(v,bf16x2_t);return __builtin_bit_cast(unsigned,b);}
#define WAIT_BAR(N) asm volatile("s_waitcnt vmcnt(" #N ") lgkmcnt(0)\n\ts_barrier":::"memory")

__device__ __forceinline__ void qkt(f32x16&p0,f32x16&p1,const char*Kslot,const bf16x8*qr,const f32x16&negm,int r32,int hi){
  const char*kb=Kslot+hi*1024+r32*16;
  #pragma unroll
  for(int d0=0;d0<4;++d0){
    const bf16x8 b0=*reinterpret_cast<const bf16x8*>(kb+d0*2048);
    const bf16x8 b1=*reinterpret_cast<const bf16x8*>(kb+d0*2048+512);
    if(d0==0){p0=__builtin_amdgcn_mfma_f32_32x32x16_bf16(b0,qr[0],negm,0,0,0);p1=__builtin_amdgcn_mfma_f32_32x32x16_bf16(b1,qr[0],negm,0,0,0);}
    else{p0=__builtin_amdgcn_mfma_f32_32x32x16_bf16(b0,qr[d0],p0,0,0,0);p1=__builtin_amdgcn_mfma_f32_32x32x16_bf16(b1,qr[d0],p1,0,0,0);}}
}
typedef __attribute__((address_space(3))) const char* lds_cptr;
typedef short v4i16_t __attribute__((ext_vector_type(4)));
__device__ __forceinline__ void kload8(bf16x8*kf,lds_cptr kp){
  kf[0]=*(const __attribute__((address_space(3))) bf16x8*)(kp);      kf[1]=*(const __attribute__((address_space(3))) bf16x8*)(kp+512);
  kf[2]=*(const __attribute__((address_space(3))) bf16x8*)(kp+2048); kf[3]=*(const __attribute__((address_space(3))) bf16x8*)(kp+2560);
  kf[4]=*(const __attribute__((address_space(3))) bf16x8*)(kp+4096); kf[5]=*(const __attribute__((address_space(3))) bf16x8*)(kp+4608);
  kf[6]=*(const __attribute__((address_space(3))) bf16x8*)(kp+6144); kf[7]=*(const __attribute__((address_space(3))) bf16x8*)(kp+6656);
}
__device__ __forceinline__ void kload2(bf16x8*kf,lds_cptr kp,int j){ kf[2*j]=*(const __attribute__((address_space(3))) bf16x8*)(kp+j*2048); kf[2*j+1]=*(const __attribute__((address_space(3))) bf16x8*)(kp+j*2048+512); }
__device__ __forceinline__ s16x4 vtr(lds_cptr p){ return __builtin_bit_cast(s16x4,__builtin_amdgcn_ds_read_tr16_b64_v4i16((__attribute__((address_space(3))) v4i16_t*)p)); }
__device__ __forceinline__ float rowmax(const f32x16&p0,const f32x16&p1){
  float a=max3f(p0[0],p0[1],p1[0]),b=max3f(p0[2],p0[3],p1[1]);a=max3f(a,p1[2],p1[3]);
  #pragma unroll
  for(int r=4;r<16;r+=4){a=max3f(a,p0[r],p0[r+1]);b=max3f(b,p0[r+2],p0[r+3]);a=max3f(a,p1[r],p1[r+1]);b=max3f(b,p1[r+2],p1[r+3]);}
  const float m=max2f(a,b);
  auto rr=__builtin_amdgcn_permlane32_swap(__float_as_uint(m),__float_as_uint(m),false,false);
  return max2f(__uint_as_float(rr[0]),__uint_as_float(rr[1]));
}
__device__ __forceinline__ void pv(f32x16*o,int vb,bf16x8 pa0,bf16x8 pa1,bf16x8 pa2,bf16x8 pa3){
  #pragma unroll
  for(int d0=0;d0<2;++d0){s16x4 lo[4],hi[4];
    #pragma unroll
    for(int ks=0;ks<4;++ks){
      asm volatile("ds_read_b64_tr_b16 %0,%1 offset:%c2":"=&v"(lo[ks]):"v"(vb),"i"(d0*4096+ks*1024):"memory");
      asm volatile("ds_read_b64_tr_b16 %0,%1 offset:%c2":"=&v"(hi[ks]):"v"(vb),"i"(d0*4096+ks*1024+512):"memory");}
    asm volatile("s_waitcnt lgkmcnt(0)":::"memory");SBAR();
    #define PK(k) (bf16x8){lo[k][0],lo[k][1],lo[k][2],lo[k][3],hi[k][0],hi[k][1],hi[k][2],hi[k][3]}
    o[d0]=__builtin_amdgcn_mfma_f32_32x32x16_bf16(pa0,PK(0),o[d0],0,0,0);
    o[d0]=__builtin_amdgcn_mfma_f32_32x32x16_bf16(pa1,PK(1),o[d0],0,0,0);
    o[d0]=__builtin_amdgcn_mfma_f32_32x32x16_bf16(pa2,PK(2),o[d0],0,0,0);
    o[d0]=__builtin_amdgcn_mfma_f32_32x32x16_bf16(pa3,PK(3),o[d0],0,0,0);
    #undef PK
  }
}

#ifndef ATTN_STORE16
#define ATTN_STORE16(p,v) (*(u32x4*)(p)=(v))
#endif
template<int THRL> __device__ __forceinline__ void attn_unit(int b,int h,int qb,const bf16*Q,const bf16*__restrict__ K,const bf16*__restrict__ V,bf16*O,const unsigned long long*__restrict__ MK,const bf16*__restrict__ SZ,char*shm){
  const int tid=threadIdx.x,lane=tid&63,r32=lane&31,hi=lane>>5; const int wid=__builtin_amdgcn_readfirstlane(tid>>6);
  const long rowbase=(long)b*SEQ; const int q0=qb*QB;
  const bf16*Qw=Q+(rowbase+q0+wid*QBLK)*DM+h*D;
  const bf16*Kh=K+rowbase*DM+h*D,*Vh=V+rowbase*DM+h*D;
  const unsigned lds0=(unsigned)(uintptr_t)shm;
  float*wsf=(float*)(shm+LDS_WS)+wid*64;
  const bf16*ksrc=Kh+(long)lane*DM+wid*8;
  const bf16*vsrc=Vh+(long)(16*(wid&3)+(lane>>2))*DM+(wid>>2)*32+(lane&3)*8;
  const unsigned kdst=lds0+LDS_K+wid*1024, vdst=lds0+LDS_V+wid*1024;
  #define DMA_K(t,slot) glds16(ksrc+(long)(t)*KVBLK*DM,(unsigned)__builtin_amdgcn_readfirstlane(kdst+(slot)))
  #define DMA_V(t,slot) glds16(vsrc+(long)(t)*KVBLK*DM,(unsigned)__builtin_amdgcn_readfirstlane(vdst+(slot)))
  const char*msrc=(const char*)(MK+((long)b*128*SEQ+q0+wid*QBLK))+lane*4; const unsigned mdst=lds0+LDS_M+wid*768;
  #define DMA_M(t,slot) glds4(msrc+(long)(t)*SEQ*8,(unsigned)__builtin_amdgcn_readfirstlane(mdst+((slot)>>5)))
  #define MWORD(slot) (*(const __attribute__((address_space(3))) unsigned long long*)(shm3+LDS_M+wid*768+((slot)>>5)+r32*8))
  const int vb0=(int)(lds0+LDS_V)+((lane>>4)&1)*32+(lane&3)*8+(4*hi+((lane&15)>>2))*64;
  const char*Kbase=shm+LDS_K; bf16x8 kf[8];
  const lds_cptr shm3=(lds_cptr)shm; const lds_cptr kp0=shm3+LDS_K+hi*1024+r32*16; const lds_cptr vp0=shm3+LDS_V+((lane>>4)&1)*32+(lane&3)*8+(4*hi+((lane&15)>>2))*64;
  const int NT=(q0+QB)/KVBLK;
  DMA_K(0,0);DMA_V(0,0);DMA_K(1,SLOTB);DMA_M(0,0);DMA_M(1,SLOTB);
  bf16x8 qr[4];
  #pragma unroll
  for(int d0=0;d0<4;++d0)qr[d0]=*reinterpret_cast<const bf16x8*>(&Qw[(long)r32*DM+d0*16+hi*8]);
  float mhat=0.f,l_reg=0.f;f32x16 o[2];o[0]=f32x16{};o[1]=f32x16{};const f32x16 negm=f32x16{};
  const int qrel=wid*QBLK+r32;
  bool resc=false;
  #define START(P0,P1) do{ const float rm=rowmax(P0,P1); resc=false; \
    { const float dl=(rm<-1e30f)?-16384.f:rm; mhat=fadd_s(mhat,dl); \
      _Pragma("unroll") for(int r=0;r<16;++r){P0[r]=fsub_s(P0[r],dl);P1[r]=fsub_s(P1[r],dl);} \
    } \
    _Pragma("unroll") for(int r=0;r<16;++r)P0[r]=__builtin_amdgcn_exp2f(P0[r]); }while(0)
  #define RESC() do{ if(resc){ asm volatile("s_waitcnt lgkmcnt(0)":::"memory"); \
      _Pragma("unroll") for(int d_=0;d_<2;++d_) _Pragma("unroll") for(int r=0;r<16;++r)o[d_][r]*=wsf[crow(r,hi)]; } }while(0)
  f32x16 pA0,pA1,pB0,pB1;
  int sl_prev=0,sl_cur=0,sl_next=SLOTB;
  #define ROT() do{sl_prev=sl_cur;sl_cur=sl_next;sl_next=(sl_next==(NSLOT-1)*SLOTB)?0:sl_next+SLOTB;}while(0)
  DMA_K(2,2*SLOTB);
  WAIT_BAR(1);
  qkt(pA0,pA1,Kbase,qr,negm,r32,hi);asm volatile("s_nop 15\n\ts_nop 7":"+v"(pA0),"+v"(pA1));kmask(pA0,pA1,MWORD(0),hi,0.f);
  START(pA0,pA1);
  _Pragma("unroll") for(int r=0;r<16;++r)pA1[r]=__builtin_amdgcn_exp2f(pA1[r]);
  WAIT_BAR(0);
  DMA_K(3,0);DMA_V(1,SLOTB);DMA_M(2,2*SLOTB);
  ROT();
  kload8(kf,kp0+sl_cur);
  WAIT_BAR(3);
  s16x4 vlo[8],vhi[8]; u32x4 pw0,pw1,pw2,pw3;
  #define PKW(P,B) cvtpk_s(P[B],P[B+1])
  #define PAF(k) __builtin_bit_cast(bf16x8,pw##k)
  #define VFR(i) (bf16x8){vlo[i][0],vlo[i][1],vlo[i][2],vlo[i][3],vhi[i][0],vhi[i][1],vhi[i][2],vhi[i][3]}
  #define PIN(x) asm volatile("":"+v"(x))
  #define MX3(a,b,c) __builtin_fmaxf(__builtin_fmaxf((a),(b)),(c))
  #define GAPA(MF,A0,A1,A2,A3,W0,W1,PW) do{ MF; sacc+=A0; sacc+=A1; sacc+=A2; sacc+=A3; PIN(sacc); W0; W1; PIN(PW); SBAR(); }while(0)
  #define EX(v) __builtin_amdgcn_exp2f(v)
  #define GAPB(MF,X,B) do{ MF; X[B]=EX(X[B]); X[B+1]=EX(X[B+1]); X[B+2]=EX(X[B+2]); X[B+3]=EX(X[B+3]); PIN(X); SBAR(); }while(0)
  #define VRD(i) do{ vlo[i]=vtr(vp_+(((i)>>2)*4096+((i)&3)*1024)); vhi[i]=vtr(vp_+(((i)>>2)*4096+((i)&3)*1024+512)); }while(0)
  #define KRD(G,j) do{ if(G){ kload2(kf,kp0+sl_next,j); SBAR(); } }while(0)
  #define STEP(C0,C1,P0,P1,t,GK,GV,GL,GM) do{ SBAR(); \
    const lds_cptr vp_=vp0+sl_prev; \
    VRD(0); SBAR(); float sacc=(P0[0]+P0[1]); \
    GAPA(C0=__builtin_amdgcn_mfma_f32_32x32x16_bf16(kf[0],qr[0],negm,0,0,0), P0[2],P0[3],P0[4],P0[5],     pw0[0]=PKW(P0,0), pw0[1]=PKW(P0,2), pw0); \
    VRD(4); SBAR(); GAPA(C1=__builtin_amdgcn_mfma_f32_32x32x16_bf16(kf[1],qr[0],negm,0,0,0), P0[6],P0[7],P0[8],P0[9],     pw0[2]=PKW(P0,4), pw0[3]=PKW(P0,6), pw0); \
    VRD(1); SBAR(); GAPA(C0=__builtin_amdgcn_mfma_f32_32x32x16_bf16(kf[2],qr[1],C0,0,0,0),   P0[10],P0[11],P0[12],P0[13], pw1[0]=PKW(P0,8), pw1[1]=PKW(P0,10), pw1); \
    VRD(5); SBAR(); GAPA(C1=__builtin_amdgcn_mfma_f32_32x32x16_bf16(kf[3],qr[1],C1,0,0,0),   P0[14],P0[15],P1[0],P1[1],   pw1[2]=PKW(P0,12),pw1[3]=PKW(P0,14), pw1); \
    VRD(2); SBAR(); GAPA(C0=__builtin_amdgcn_mfma_f32_32x32x16_bf16(kf[4],qr[2],C0,0,0,0),   P1[2],P1[3],P1[4],P1[5],     pw2[0]=PKW(P1,0), pw2[1]=PKW(P1,2), pw2); \
    VRD(6); SBAR(); GAPA(C1=__builtin_amdgcn_mfma_f32_32x32x16_bf16(kf[5],qr[2],C1,0,0,0),   P1[6],P1[7],P1[8],P1[9],     pw2[2]=PKW(P1,4), pw2[3]=PKW(P1,6), pw2); \
    VRD(3); SBAR(); GAPA(C0=__builtin_amdgcn_mfma_f32_32x32x16_bf16(kf[6],qr[3],C0,0,0,0),   P1[10],P1[11],P1[12],P1[13], pw3[0]=PKW(P1,8), pw3[1]=PKW(P1,10), pw3); \
    VRD(7); SBAR(); GAPA(C1=__builtin_amdgcn_mfma_f32_32x32x16_bf16(kf[7],qr[3],C1,0,0,0),   P1[14],P1[15],0.f,0.f,       pw3[2]=PKW(P1,12),pw3[3]=PKW(P1,14), pw3); \
    l_reg+=sacc; \
    if(GK){DMA_K((t)+3,sl_cur);} if(GV){DMA_V((t)+1,sl_next);} if(GM){DMA_M((t)+2,sl_prev);} \
    kmask(C0,C1,MWORD(sl_cur),hi,-mhat); \
    { float a=MX3(C0[0],C0[1],C1[0]),b=MX3(C0[2],C0[3],C1[1]); a=MX3(a,C1[2],C1[3]); \
      _Pragma("unroll") for(int r=4;r<16;r+=4){a=MX3(a,C0[r],C0[r+1]);b=MX3(b,C0[r+2],C0[r+3]);a=MX3(a,C1[r],C1[r+1]);b=MX3(b,C1[r+2],C1[r+3]);} \
      float rm=__builtin_fmaxf(a,b); { auto rr=__builtin_amdgcn_permlane32_swap(__float_as_uint(rm),__float_as_uint(rm),false,false); rm=__builtin_fmaxf(__uint_as_float(rr[0]),__uint_as_float(rr[1])); } \
      resc=false; \
      if(__builtin_expect(__any(rm>(float)THRL),0)){ const float dl=__builtin_fmaxf(rm,0.f); mhat+=dl; \
        _Pragma("unroll") for(int r=0;r<16;++r){C0[r]-=dl;C1[r]-=dl;} \
        const float f=__builtin_amdgcn_exp2f(-dl); l_reg*=f; if(hi==0)wsf[r32]=f; resc=true; } } \
    SBAR(); \
    GAPB(o[0]=__builtin_amdgcn_mfma_f32_32x32x16_bf16(PAF(0),VFR(0),o[0],0,0,0), C0,0); \
    GAPB(o[1]=__builtin_amdgcn_mfma_f32_32x32x16_bf16(PAF(0),VFR(4),o[1],0,0,0), C0,4); \
    KRD(GL,0); GAPB(o[0]=__builtin_amdgcn_mfma_f32_32x32x16_bf16(PAF(1),VFR(1),o[0],0,0,0), C0,8); \
    KRD(GL,1); GAPB(o[1]=__builtin_amdgcn_mfma_f32_32x32x16_bf16(PAF(1),VFR(5),o[1],0,0,0), C0,12); \
    KRD(GL,2); GAPB(o[0]=__builtin_amdgcn_mfma_f32_32x32x16_bf16(PAF(2),VFR(2),o[0],0,0,0), C1,0); \
    KRD(GL,3); GAPB(o[1]=__builtin_amdgcn_mfma_f32_32x32x16_bf16(PAF(2),VFR(6),o[1],0,0,0), C1,4); \
    GAPB(o[0]=__builtin_amdgcn_mfma_f32_32x32x16_bf16(PAF(3),VFR(3),o[0],0,0,0), C1,8); \
    GAPB(o[1]=__builtin_amdgcn_mfma_f32_32x32x16_bf16(PAF(3),VFR(7),o[1],0,0,0), C1,12); \
    }while(0)
  int t=1;
  for(;t+5<NT;t+=2){
    STEP(pB0,pB1,pA0,pA1,t,true,true,true,true);     WAIT_BAR(3); RESC(); ROT();
    STEP(pA0,pA1,pB0,pB1,t+1,true,true,true,true);   WAIT_BAR(3); RESC(); ROT();
  }
  #define ENDW(tt) do{ if((tt)+3<NT){WAIT_BAR(3);} else if((tt)+2<NT){WAIT_BAR(2);} else {WAIT_BAR(0);} }while(0)
  for(;t+1<NT;t+=2){
    STEP(pB0,pB1,pA0,pA1,t,(t+3<NT),(t+1<NT),(t+1<NT),(t+2<NT));       ENDW(t);   RESC(); ROT();
    STEP(pA0,pA1,pB0,pB1,t+1,(t+4<NT),(t+2<NT),(t+2<NT),(t+3<NT));     ENDW(t+1); RESC(); ROT();
  }
  STEP(pB0,pB1,pA0,pA1,NT-1,false,false,false,false); RESC();
  { float sacc=pB0[0]+pB0[1]; _Pragma("unroll") for(int r=2;r<16;++r)sacc+=pB0[r]; _Pragma("unroll") for(int r=0;r<16;++r)sacc+=pB1[r]; l_reg+=sacc;
    pw0=(u32x4){PKW(pB0,0),PKW(pB0,2),PKW(pB0,4),PKW(pB0,6)};pw1=(u32x4){PKW(pB0,8),PKW(pB0,10),PKW(pB0,12),PKW(pB0,14)};pw2=(u32x4){PKW(pB1,0),PKW(pB1,2),PKW(pB1,4),PKW(pB1,6)};pw3=(u32x4){PKW(pB1,8),PKW(pB1,10),PKW(pB1,12),PKW(pB1,14)};
    SBAR(); pv(o,vb0+sl_cur,PAF(0),PAF(1),PAF(2),PAF(3)); }
  #undef PKW
  #undef PAF
  #undef VFR
  #undef PIN
  #undef MX3
  #undef GAPA
  #undef GAPB
  #undef EX
  #undef VRD
  #undef KRD
  #undef STEP
  #undef ENDW
  {auto rr=__builtin_amdgcn_permlane32_swap(__float_as_uint(l_reg),__float_as_uint(l_reg),false,false);l_reg=__uint_as_float(rr[0])+__uint_as_float(rr[1]);}
  if(hi==0)wsf[32+r32]=l_reg;asm volatile("s_waitcnt lgkmcnt(0)":::"memory");
  float rli[16];
  #pragma unroll
  for(int r=0;r<16;++r)rli[r]=__builtin_amdgcn_rcpf(wsf[32+crow(r,hi)]);
  bf16*Ow=O+(rowbase+q0+wid*QBLK)*DM+h*D; const bf16*Zw=SZ+(rowbase+q0+wid*QBLK)*DM+h*D;
  { bf16*stg=(bf16*)(shm+LDS_OST)+wid*2048;
    #pragma unroll
    for(int r=0;r<16;++r){const int orow=crow(r,hi);
      #pragma unroll
      for(int d0=0;d0<2;++d0)stg[orow*64+d0*32+r32]=__float2bfloat16(o[d0][r]*rli[r]);}
    asm volatile("s_waitcnt lgkmcnt(0)":::"memory");
    #pragma unroll
    for(int i=0;i<4;++i){const int row=i*8+(lane>>3),ch=lane&7; const u32x4 v=*(const u32x4*)(stg+row*64+ch*8); const u32x4 z=*(const u32x4*)(Zw+(long)row*DM+ch*8); u32x4 y;
      y.x=cvtpk_s(__uint_as_float(v.x<<16)*__uint_as_float(z.x<<16),__uint_as_float(v.x&0xffff0000u)*__uint_as_float(z.x&0xffff0000u));
      y.y=cvtpk_s(__uint_as_float(v.y<<16)*__uint_as_float(z.y<<16),__uint_as_float(v.y&0xffff0000u)*__uint_as_float(z.y&0xffff0000u));
      y.z=cvtpk_s(__uint_as_float(v.z<<16)*__uint_as_float(z.z<<16),__uint_as_float(v.z&0xffff0000u)*__uint_as_float(z.z&0xffff0000u));
      y.w=cvtpk_s(__uint_as_float(v.w<<16)*__uint_as_float(z.w<<16),__uint_as_float(v.w&0xffff0000u)*__uint_as_float(z.w&0xffff0000u));
      ATTN_STORE16(Ow+(long)row*DM+ch*8,y);} }
  asm volatile("s_waitcnt lgkmcnt(0)\n\ts_barrier":::"memory");
  #undef DMA_K
  #undef DMA_V
  #undef DMA_M
  #undef MWORD
  #undef START
  #undef RESC
  #undef ROT
}
constexpr int ATTN_LDS_BYTES=LDS_BYTES;
struct AttnTensors { const bf16* Q; const bf16* K; const bf16* V; bf16* O; const unsigned long long* MK; const bf16* SZ; };
struct AttnUnit { int bh; int qb; };
struct StaticOrder {
  int vcu;
  __device__ __forceinline__ explicit StaticOrder(int grid,int block):vcu((block%8)*(grid/8)+block/8){}
  __device__ __forceinline__ bool next(int i,AttnUnit&u)const{ if(i>=2)return false; const int s=vcu&15; u.bh=vcu>>4; u.qb=(i==0)?s:31-s; return true; }
  __device__ __forceinline__ void a_ready(const AttnUnit&)const{}
  __device__ __forceinline__ void done(const AttnUnit&)const{}
};
template<class Sched,int THRL=8> __device__ __forceinline__ void attn_phase(char*lds,const AttnTensors&T,const Sched&S){
  AttnUnit u;
  for(int i=0;S.next(i,u);++i){ S.a_ready(u); attn_unit<THRL>(u.bh/NHEAD,u.bh%NHEAD,u.qb,T.Q,T.K,T.V,T.O,T.MK,T.SZ,lds); S.done(u); }
}
#undef SBAR
#undef WAIT_BAR
}
#define GAS __attribute__((address_space(1)))
#define LAS __attribute__((address_space(3)))
typedef unsigned short bf16;
typedef unsigned v4u __attribute__((ext_vector_type(4)));
typedef float f32x4 __attribute__((ext_vector_type(4)));
typedef short bf16x8 __attribute__((ext_vector_type(8)));
typedef GAS unsigned gu32;
typedef GAS unsigned long long gu64;
#define RLX_AGENT __ATOMIC_RELAXED, __HIP_MEMORY_SCOPE_AGENT
#define LDS_WAIT() asm volatile("s_waitcnt lgkmcnt(0)" ::: "memory")
#define VM_WAIT() asm volatile("s_waitcnt vmcnt(0)" ::: "memory")
__device__ __forceinline__ unsigned long long rt() { return __builtin_amdgcn_s_memrealtime(); }
__device__ __forceinline__ unsigned f2bf(float f) { unsigned u = __builtin_bit_cast(unsigned, f); return (u + 0x7fffu + ((u >> 16) & 1u)) >> 16; }
__device__ __forceinline__ unsigned pk2(float lo, float hi) { return f2bf(lo) | (f2bf(hi) << 16); }

#define XB_TMO      128
#define XB_XCNT(j)  (256  + 64 * (j))
#define XB_XSUB(j)  (1280 + 64 * (j))
#define XB_XGEN(j)  (2304 + 64 * (j))
#define XB_TOP      3328
#define XB_TOPGEN   3392
#define XCD_BAR_WORDS 3456
#define XB_SPIN_CAP (1u << 18)

__device__ __forceinline__ unsigned xb_ld(unsigned* p)              { return __hip_atomic_load(p, __ATOMIC_RELAXED, __HIP_MEMORY_SCOPE_AGENT); }
__device__ __forceinline__ unsigned xb_add(unsigned* p, unsigned v) { return __hip_atomic_fetch_add(p, v, __ATOMIC_RELAXED, __HIP_MEMORY_SCOPE_AGENT); }
__device__ __forceinline__ unsigned xb_xcc_id() { return (unsigned)__builtin_amdgcn_s_getreg((3 << 11) | 20) & 0xFu; }
#define XB_SPIN(cond, bar) do { unsigned _sp = 0; while (cond) { __builtin_amdgcn_s_sleep(1); \
    if ((++_sp & 255u) == 0u) { if (xb_ld(&(bar)[XB_TMO])) break; if (_sp > XB_SPIN_CAP) { atomicAdd(&(bar)[XB_TMO], 1u); break; } } } } while (0)

struct XcdBarrier {
    unsigned* bar; unsigned x;
    volatile LAS unsigned* st;
};

__device__ __forceinline__ XcdBarrier xcd_barrier_post(unsigned* bar, volatile LAS unsigned* st) {
    XcdBarrier b; b.bar = bar; b.x = xb_xcc_id(); b.st = st;
    if (threadIdx.x == 0) (void)xb_add(&bar[XB_XCNT(b.x)], 1u);
    return b;
}
__device__ __forceinline__ void xcd_barrier_complete(unsigned* bar, unsigned x, unsigned& nloc, unsigned& nx) {
    const unsigned G = gridDim.x * gridDim.y * gridDim.z;
    unsigned sum, cnt, mine, sp = 0u;
    for (;;) {
        sum = 0u; cnt = 0u; mine = 0u;
#pragma unroll
        for (unsigned j = 0; j < 16; ++j) { const unsigned c = xb_ld(&bar[XB_XCNT(j)]); sum += c; cnt += (c > 0u) ? 1u : 0u; mine = (j == x) ? c : mine; }
        if (sum == G) break;
        __builtin_amdgcn_s_sleep(1);
        if ((++sp & 255u) == 0u) { if (xb_ld(&bar[XB_TMO])) break; if (sp > XB_SPIN_CAP) { atomicAdd(&bar[XB_TMO], 1u); break; } }
    }
    nloc = mine > 0u ? mine : 1u; nx = cnt > 0u ? cnt : 1u;
}

__device__ __forceinline__ void xcd_barrier(const XcdBarrier& b) {
    asm volatile("s_waitcnt vmcnt(0)" ::: "memory");
    __syncthreads();
    if (threadIdx.x == 0) {
        unsigned* bar = b.bar;
        __builtin_amdgcn_s_waitcnt(0);
        unsigned nloc = b.st[0], nx = b.st[1];
        if (nloc == 0u) { xcd_barrier_complete(bar, b.x, nloc, nx); b.st[0] = nloc; b.st[1] = nx; }
        const unsigned old = xb_add(&bar[XB_XSUB(b.x)], 1u);
        const unsigned gen = old / nloc;
        if (old + 1u == (gen + 1u) * nloc) {
            __builtin_amdgcn_fence(__ATOMIC_RELEASE, "agent");
            asm volatile("s_waitcnt vmcnt(0)" ::: "memory");
            const unsigned og = xb_add(&bar[XB_TOP], 1u);
            const unsigned tg = og / nx;
            if (og + 1u == (tg + 1u) * nx) xb_add(&bar[XB_TOPGEN], 1u);
            else XB_SPIN(xb_ld(&bar[XB_TOPGEN]) == tg, bar);
            __builtin_amdgcn_fence(__ATOMIC_ACQUIRE, "agent");
            xb_add(&bar[XB_XGEN(b.x)], 1u);
            asm volatile("s_waitcnt vmcnt(0)" ::: "memory");
        } else {
            XB_SPIN(xb_ld(&bar[XB_XGEN(b.x)]) == gen, bar);
            __builtin_amdgcn_fence(__ATOMIC_ACQUIRE, "agent");
            asm volatile("s_waitcnt vmcnt(0)" ::: "memory");
        }
    }
    __syncthreads();
}
constexpr int NWAVES = 8;
#ifndef MK_N_LAUNCHES
#define MK_N_LAUNCHES 1
#endif
constexpr int N_PHASES = 9;
constexpr int N_LAUNCHES = MK_N_LAUNCHES;

constexpr size_t MiB = 1u << 20;
constexpr size_t WS_CTL = 0, CTL_ZERO_BYTES = 1 * MiB;
constexpr size_t WS_WIN = 2 * MiB;
constexpr size_t WS_WPA = 16 * MiB, WS_WPR = 17 * MiB, WS_WOUT = 18 * MiB;
constexpr size_t WS_ROPE = 20 * MiB;
constexpr size_t WS_H = 24 * MiB;
constexpr size_t WS_QA = 57 * MiB, WS_KA = 74 * MiB, WS_VA = 91 * MiB, WS_SZA = 108 * MiB;
constexpr size_t WS_QI = 125 * MiB, WS_KI = 134 * MiB, WS_WI = 137 * MiB;
constexpr size_t WS_QR = 138 * MiB, WS_KR = 155 * MiB, WS_VR = 172 * MiB, WS_SZR = 189 * MiB;
constexpr size_t WS_SGA = 206 * MiB, WS_SGR = 239 * MiB;
constexpr size_t WS_YA = 272 * MiB, WS_YR = 289 * MiB;
constexpr size_t WS_T1 = 306 * MiB, WS_MG = 339 * MiB;
constexpr size_t WS_MASK = 372 * MiB;
constexpr size_t WS_KVL = 388 * MiB;
constexpr size_t WS_SSC = 396 * MiB;
constexpr size_t WS_END = 402 * MiB;
constexpr int SSC_LD = 8256;
static_assert(WS_WIN + (size_t)NINP * D * 2 <= WS_WPA && WS_ROPE + (size_t)8196 * 64 * 4 <= WS_H && WS_H + (size_t)MT * D * 2 <= WS_QA && WS_QA + (size_t)MT * WA * 2 <= WS_KA, "ws map");
static_assert(WS_QI + (size_t)MT * 256 * 2 <= WS_KI && WS_KI + (size_t)MT * 64 * 2 <= WS_WI && WS_WI + (size_t)MT * 16 <= WS_QR && WS_SGA + (size_t)MT * D * 2 <= WS_SGR && WS_SGR + (size_t)MT * D * 2 <= WS_YA, "ws map");
static_assert(WS_T1 + (size_t)MT * D * 2 <= WS_MG && WS_MG + (size_t)MT * D * 2 <= WS_MASK && WS_MASK + (size_t)2 * 128 * 8192 * 8 <= WS_KVL && WS_KVL + (size_t)2 * 8 * 32 * 4096 * 4 <= WS_SSC && WS_SSC + (size_t)MS * SSC_LD * 4 <= WS_END, "ws map");
constexpr int CW_TMO = 0, CW_CODE = 1;
constexpr int CW_BAR = 4096;
constexpr int CW_MOD = 16384;
static_assert((CW_MOD + NMOD * 3 * D) * 4 <= (int)CTL_ZERO_BYTES, "CTL words inside the memset region");

constexpr int RING_OFF = 0, RING_BYTES = 131072;
constexpr int LDSCTL_OFF = RING_BYTES, MISC_OFF = LDSCTL_OFF + 320;
constexpr int LDS_BYTES = 147456;
static_assert(MISC_OFF + 128 <= LDS_BYTES, "LDS map");
struct Frame {
    LAS unsigned char* lds;
    volatile LAS unsigned* MISC;
    gu32* ctl;
    int tid, lane, wave;
    int vcu, G;
    unsigned char* ws;
    const float *x_p, *x_s, *cache_k, *cache_v, *cache_ki, *state_ret; const int* page_table; const float *c_p, *c_s, *w_ada, *b_ada, *g_norm, *w_in, *g_ret, *w_pa, *w_pr, *w_out, *g_final;
    float* out;
};
__device__ __forceinline__ float wave_sum(float v) {
#pragma unroll
    for (int o = 1; o < 64; o <<= 1) v += __shfl_xor(v, o);
    return v;
}
__device__ __forceinline__ void p0_transpose_item(const float* W, int K, int N, bf16* WT, int nsrc, int cnt, int drow, int kb, LAS float* scr, int lane) {
    const int k0 = 64 * kb, nl = lane & 31;
#pragma unroll 8
    for (int i = 0; i < 32; ++i) { const int kk = 2 * i + (lane >> 5); scr[kk * 33 + nl] = (nsrc >= 0 && nl < cnt) ? W[(size_t)(k0 + kk) * N + nsrc + nl] : 0.f; }
    LDS_WAIT(); asm volatile("" ::: "memory");
    const int c = lane & 7;
#pragma unroll
    for (int j = 0; j < 4; ++j) { const int n = (lane >> 3) + 8 * j; const LAS float* s = scr + (8 * c) * 33 + n;
        v4u o; o.x = pk2(s[0 * 33], s[1 * 33]); o.y = pk2(s[2 * 33], s[3 * 33]); o.z = pk2(s[4 * 33], s[5 * 33]); o.w = pk2(s[6 * 33], s[7 * 33]);
        *(GAS v4u*)(WT + (size_t)(drow + n) * K + k0 + 8 * c) = o; }
    LDS_WAIT(); asm volatile("" ::: "memory");
}
__device__ __forceinline__ void win_group(int pg, int& nsrc, int& cnt) {
    const int pn = pg >> 3, gi = pg & 7, bj = gi >> 2, jg = gi & 3; cnt = 32;
    if (pn < 8) nsrc = pn * 256 + gi * 32;
    else if (pn == 8) nsrc = 2048 + gi * 32;
    else if (pn == 9) { if (gi < 2) nsrc = 2304 + gi * 32; else if (gi == 2) { nsrc = 2368; cnt = 4; } else nsrc = -1; }
    else if (pn < 14) { const int segbase = pn < 12 ? 2372 : 2884, head = 4 * ((pn - 10) & 1) + jg; nsrc = segbase + head * 64 + 32 * bj; }
    else if (pn < 18) nsrc = 3396 + (pn - 14) * 256 + gi * 32;
    else { const int g = pn - 18; nsrc = (bj == 0 ? 4420 : 5444) + 128 * g + 32 * jg; }
}
__device__ __forceinline__ float siluf_(float x) { return x * __builtin_amdgcn_rcpf(1.0f + __builtin_amdgcn_exp2f(-1.4426950408889634f * x)); }

__device__ __forceinline__ void p0_prologue(Frame& F) {
    LAS float* scr = (LAS float*)(F.lds + RING_OFF + F.wave * 16384);
    const int gw = F.vcu * NWAVES + F.wave, NGW = F.G * NWAVES;
    bf16* WIN = (bf16*)(F.ws + WS_WIN); bf16* WPA = (bf16*)(F.ws + WS_WPA); bf16* WPR = (bf16*)(F.ws + WS_WPR); bf16* WOUT = (bf16*)(F.ws + WS_WOUT);
    constexpr int I_IN = (NINP / 32) * (D / 64), I_PA = (D / 32) * (WA / 64), I_OUT = (D / 32) * (D / 64), I_MOD = 48 * 16;
    constexpr int NITEMS = I_MOD + I_IN + 2 * I_PA + I_OUT;
    for (int it = gw; it < NITEMS; it += NGW) {
        int r = it;
        if (r < I_MOD) {
            const int cg = r % 48, ks = r / 48, n = cg * 64 + F.lane, k0 = ks * 64;
            for (int i = F.lane; i < NMOD * 64; i += 64) { const int row = i >> 6, kk = i & 63; const float cv = row < 2 ? F.c_p[row * D + k0 + kk] : F.c_s[(row - 2) * D + k0 + kk]; scr[kk * 36 + row] = siluf_(cv); }
            LDS_WAIT(); asm volatile("" ::: "memory");
            float acc[NMOD];
#pragma unroll
            for (int j = 0; j < NMOD; ++j) acc[j] = 0.f;
#pragma unroll 4
            for (int kk = 0; kk < 64; ++kk) { const float w = F.w_ada[(size_t)(k0 + kk) * (3 * D) + n];
#pragma unroll
                for (int j = 0; j < NMOD; ++j) acc[j] += scr[kk * 36 + j] * w; }
            float* mod = (float*)(F.ctl + CW_MOD);
#pragma unroll
            for (int j = 0; j < NMOD; ++j) atomicAdd(mod + (size_t)j * 3 * D + n, acc[j]);
            LDS_WAIT(); asm volatile("" ::: "memory");
            continue;
        }
        r -= I_MOD;
        if (r < I_IN) { const int pg = r / (D / 64), kb = r % (D / 64); int nsrc, cnt; win_group(pg, nsrc, cnt); p0_transpose_item(F.w_in, D, NIN, WIN, nsrc, cnt, pg * 32, kb, scr, F.lane); continue; }
        r -= I_IN;
        if (r < I_PA) { const int pg = r / (WA / 64), kb = r % (WA / 64); p0_transpose_item(F.w_pa, WA, D, WPA, pg * 32, 32, pg * 32, kb, scr, F.lane); continue; }
        r -= I_PA;
        if (r < I_PA) { const int pg = r / (WA / 64), kb = r % (WA / 64); p0_transpose_item(F.w_pr, WA, D, WPR, pg * 32, 32, pg * 32, kb, scr, F.lane); continue; }
        r -= I_PA;
        { const int pg = r / (D / 64), kb = r % (D / 64); p0_transpose_item(F.w_out, D, D, WOUT, pg * 32, 32, pg * 32, kb, scr, F.lane); }
    }
    float* rope = (float*)(F.ws + WS_ROPE);
    for (int i = gw * 64 + F.lane; i < 8196 * 32; i += NGW * 64) { const int pos = i >> 5, d = i & 31;
        const float inv = __builtin_amdgcn_exp2f(-(float)d * 0.41524101186092029f); const float ang = (float)pos * inv;
        const float nrev = __builtin_rintf(ang * 0.15915494309189535f); float rr = __builtin_fmaf(-nrev, 6.2831854820251465f, ang); rr = __builtin_fmaf(-nrev, -1.7484555e-7f, rr);
        const float rev = rr * 0.15915494309189535f;
        *(float2*)(rope + (size_t)i * 2) = make_float2(__builtin_amdgcn_cosf(rev), __builtin_amdgcn_sinf(rev)); }
}
__device__ __forceinline__ void p1_hrows(Frame& F) {
    const int gw = F.vcu * NWAVES + F.wave, NGW = F.G * NWAVES;
    const float* mod = (const float*)(F.ctl + CW_MOD); bf16* H = (bf16*)(F.ws + WS_H);
    for (int m = gw; m < MT; m += NGW) {
        GAS unsigned long long* o8 = (GAS unsigned long long*)(H + (size_t)m * D) + F.lane;
        if (m >= MR) {
#pragma unroll
            for (int j = 0; j < 4; ++j) o8[64 * j] = 0ull;
            continue; }
        const float* xrow = m < MP ? F.x_p + (size_t)m * D : F.x_s + (size_t)(m - MP) * D; const int mr = m < MP ? m / SEQ : 2 + ((m - MP) >> 2);
        const GAS f32x4* xr = (const GAS f32x4*)xrow + F.lane;
        f32x4 v[4]; float s = 0.f;
#pragma unroll
        for (int j = 0; j < 4; ++j) { v[j] = xr[64 * j]; s += (v[j].x * v[j].x + v[j].y * v[j].y) + (v[j].z * v[j].z + v[j].w * v[j].w); }
        const float rstd = 1.0f / sqrtf(wave_sum(s) * (1.f / D) + EPS);
#pragma unroll
        for (int j = 0; j < 4; ++j) { const int col = 4 * F.lane + 256 * j;
            const f32x4 g = *(const f32x4*)(F.g_norm + col);
            const f32x4 sh = *(const f32x4*)(mod + (size_t)mr * 3 * D + col) + *(const f32x4*)(F.b_ada + col);
            const f32x4 sc = *(const f32x4*)(mod + (size_t)mr * 3 * D + D + col) + *(const f32x4*)(F.b_ada + D + col);
            const f32x4 hv = (v[j] * rstd) * g * (sc + 1.0f) + sh;
            o8[64 * j] = (unsigned long long)pk2(hv.x, hv.y) | ((unsigned long long)pk2(hv.z, hv.w) << 32); }
    }
}
__device__ __forceinline__ void p8_final(Frame& F) {
    const int gw = F.vcu * NWAVES + F.wave, NGW = F.G * NWAVES;
    for (int m = gw; m < MR; m += NGW) {
        GAS f32x4* yr = (GAS f32x4*)(F.out + (size_t)m * D) + F.lane;
        f32x4 v[4]; float s = 0.f;
#pragma unroll
        for (int j = 0; j < 4; ++j) { v[j] = yr[64 * j]; s += (v[j].x * v[j].x + v[j].y * v[j].y) + (v[j].z * v[j].z + v[j].w * v[j].w); }
        const float rstd = 1.0f / sqrtf(wave_sum(s) * (1.f / D) + EPS);
#pragma unroll
        for (int j = 0; j < 4; ++j) { const f32x4 g = *(const f32x4*)(F.g_final + 4 * F.lane + 256 * j); yr[64 * j] = (v[j] * rstd) * g; }
    }
}
typedef float f32x16 __attribute__((ext_vector_type(16)));
typedef short s16x4 __attribute__((ext_vector_type(4)));
__device__ __forceinline__ float l2gamma(int h) {
    const float x = __builtin_ldexpf(1.0f, -5 - h);
    const float p = x * (1.0f + x * (0.5f + x * (0.33333334f + x * (0.25f + x * (0.2f + x * 0.16666667f)))));
    return -p * 1.4426950408889634f;
}
__device__ __forceinline__ int crow16(int r, int hi) { return (r & 3) + 8 * (r >> 2) + 4 * hi; }
constexpr int RC = 256, NCH = SEQ / RC;
constexpr int R_TS = 264;
constexpr int R_KS = 72;
__device__ __forceinline__ void ret_local_unit(Frame& F, int b, int h, int c) {
    const bf16* KR = (const bf16*)(F.ws + WS_KR); const bf16* VR = (const bf16*)(F.ws + WS_VR); float* KVL = (float*)(F.ws + WS_KVL);
    LAS bf16* AT = (LAS bf16*)(F.lds + RING_OFF); LAS bf16* BT = AT + 64 * R_TS; LAS float* RED = (LAS float*)(F.lds + RING_OFF + 2 * 64 * R_TS * 2);
    const int tid = F.tid, lane = F.lane, w = F.wave; const float lg = l2gamma(h);
    const size_t R0 = (size_t)b * SEQ + (size_t)c * RC;
    {   const int j = tid >> 1, half = tid & 1; const float sc = __builtin_amdgcn_exp2f((float)(RC - 1 - j) * lg);
        const v4u* kp = (const v4u*)(KR + (R0 + j) * WA + h * 64 + 32 * half); const v4u* vp = (const v4u*)(VR + (R0 + j) * WA + h * 64 + 32 * half);
#pragma unroll
        for (int i = 0; i < 4; ++i) { const v4u kw = kp[i], vw = vp[i]; const unsigned ka[4] = {kw.x, kw.y, kw.z, kw.w}, va[4] = {vw.x, vw.y, vw.z, vw.w};
#pragma unroll
            for (int e = 0; e < 4; ++e) { const int d = 32 * half + 8 * i + 2 * e;
                AT[d * R_TS + j] = (bf16)f2bf(pg8::bf_lo(ka[e]) * sc); AT[(d + 1) * R_TS + j] = (bf16)f2bf(pg8::bf_hi(ka[e]) * sc);
                BT[d * R_TS + j] = (bf16)(va[e] & 0xffffu); BT[(d + 1) * R_TS + j] = (bf16)(va[e] >> 16); } }
    }
    __syncthreads();
    const int tile = w & 3, mt = tile >> 1, nt = tile & 1, kh = w >> 2, l32 = lane & 31, hi = lane >> 5;
    f32x16 acc = {};
#pragma unroll
    for (int ks = 0; ks < 8; ++ks) { const int k0 = 16 * (8 * kh + ks) + 8 * hi;
        const bf16x8 a = *(const LAS bf16x8*)(AT + (32 * mt + l32) * R_TS + k0); const bf16x8 bq = *(const LAS bf16x8*)(BT + (32 * nt + l32) * R_TS + k0);
        acc = __builtin_amdgcn_mfma_f32_32x32x16_bf16(a, bq, acc, 0, 0, 0); }
    if (kh == 1) {
#pragma unroll
        for (int r = 0; r < 16; ++r) RED[tile * 1024 + r * 64 + lane] = acc[r]; }
    __syncthreads();
    if (kh == 0) { float* o = KVL + (((size_t)(b * NH + h) * NCH + c) << 12);
#pragma unroll
        for (int r = 0; r < 16; ++r) o[(32 * mt + crow16(r, hi)) * 64 + 32 * nt + l32] = acc[r] + RED[tile * 1024 + r * 64 + lane]; }
    __syncthreads();
}
__device__ __forceinline__ void ret_out_unit(Frame& F, int b, int h, int c) {
    const bf16* QR = (const bf16*)(F.ws + WS_QR); const bf16* KR = (const bf16*)(F.ws + WS_KR); const bf16* VR = (const bf16*)(F.ws + WS_VR); const bf16* SZR = (const bf16*)(F.ws + WS_SZR);
    bf16* YR = (bf16*)(F.ws + WS_YR); const float* KVL = (const float*)(F.ws + WS_KVL) + (((size_t)(b * NH + h) * NCH) << 12);
    LAS bf16* Ks = (LAS bf16*)(F.lds + RING_OFF); LAS bf16* VT = Ks + RC * R_KS; LAS bf16* SpT = VT + 64 * R_TS;
    const int tid = F.tid, lane = F.lane, w = F.wave, l32 = lane & 31, hi = lane >> 5; const float lg = l2gamma(h);
    const size_t R0 = (size_t)b * SEQ + (size_t)c * RC;
    {
        const float gC = __builtin_amdgcn_exp2f((float)RC * lg), g1 = __builtin_amdgcn_exp2f(lg);
        f32x4 s0 = {0.f, 0.f, 0.f, 0.f}, s1 = {0.f, 0.f, 0.f, 0.f}; const float* kp = KVL + tid * 8;
        for (int m = 0; m < c; ++m) { const f32x4 a0 = *(const f32x4*)(kp + ((size_t)m << 12)), a1 = *(const f32x4*)(kp + ((size_t)m << 12) + 4); s0 = s0 * gC + a0; s1 = s1 * gC + a1; }
        const int dk = tid >> 3, dv0 = (tid & 7) * 8;
#pragma unroll
        for (int e = 0; e < 4; ++e) { SpT[(dv0 + e) * R_KS + dk] = (bf16)f2bf(s0[e] * g1); SpT[(dv0 + 4 + e) * R_KS + dk] = (bf16)f2bf(s1[e] * g1); }
        if (c == NCH - 1) { const f32x4 a0 = *(const f32x4*)(kp + ((size_t)c << 12)), a1 = *(const f32x4*)(kp + ((size_t)c << 12) + 4);
            float* o = F.out + O_RSP + ((size_t)(b * NH + h) << 12) + tid * 8; *(f32x4*)o = s0 * gC + a0; *(f32x4*)(o + 4) = s1 * gC + a1; }
    }
    {   const int j = tid >> 1, half = tid & 1; const float sc = __builtin_amdgcn_exp2f(-(float)j * lg);
        const v4u* kp = (const v4u*)(KR + (R0 + j) * WA + h * 64 + 32 * half); const v4u* vp = (const v4u*)(VR + (R0 + j) * WA + h * 64 + 32 * half);
#pragma unroll
        for (int i = 0; i < 4; ++i) { const v4u kw = kp[i], vw = vp[i]; const unsigned va[4] = {vw.x, vw.y, vw.z, vw.w};
            v4u ko; ko.x = pk2(pg8::bf_lo(kw.x) * sc, pg8::bf_hi(kw.x) * sc); ko.y = pk2(pg8::bf_lo(kw.y) * sc, pg8::bf_hi(kw.y) * sc); ko.z = pk2(pg8::bf_lo(kw.z) * sc, pg8::bf_hi(kw.z) * sc); ko.w = pk2(pg8::bf_lo(kw.w) * sc, pg8::bf_hi(kw.w) * sc);
            *(LAS v4u*)(Ks + j * R_KS + 32 * half + 8 * i) = ko;
#pragma unroll
            for (int e = 0; e < 4; ++e) { const int d = 32 * half + 8 * i + 2 * e; VT[d * R_TS + j] = (bf16)(va[e] & 0xffffu); VT[(d + 1) * R_TS + j] = (bf16)(va[e] >> 16); } }
    }
    bf16x8 qf[4];
    {   const int i = 32 * w + l32; const float sc = __builtin_amdgcn_exp2f((float)i * lg); const bf16* qp = QR + (R0 + i) * WA + h * 64 + 8 * hi;
#pragma unroll
        for (int ks = 0; ks < 4; ++ks) { const v4u qw = *(const v4u*)(qp + 16 * ks); v4u o;
            o.x = pk2(pg8::bf_lo(qw.x) * sc, pg8::bf_hi(qw.x) * sc); o.y = pk2(pg8::bf_lo(qw.y) * sc, pg8::bf_hi(qw.y) * sc); o.z = pk2(pg8::bf_lo(qw.z) * sc, pg8::bf_hi(qw.z) * sc); o.w = pk2(pg8::bf_lo(qw.w) * sc, pg8::bf_hi(qw.w) * sc);
            qf[ks] = __builtin_bit_cast(bf16x8, o); }
    }
    __syncthreads();
    f32x16 o0 = {}, o1 = {};
    for (int jb = 0; jb <= w; ++jb) {
        f32x16 s = {};
#pragma unroll
        for (int ks = 0; ks < 4; ++ks) { const bf16x8 a = *(const LAS bf16x8*)(Ks + (32 * jb + l32) * R_KS + 16 * ks + 8 * hi); s = __builtin_amdgcn_mfma_f32_32x32x16_bf16(a, qf[ks], s, 0, 0, 0); }
        if (jb == w) {
#pragma unroll
            for (int r = 0; r < 16; ++r) if (crow16(r, hi) > l32) s[r] = 0.f; }
#pragma unroll
        for (int sx = 0; sx < 2; ++sx) { v4u pw; pw.x = pk2(s[8 * sx + 0], s[8 * sx + 1]); pw.y = pk2(s[8 * sx + 2], s[8 * sx + 3]); pw.z = pk2(s[8 * sx + 4], s[8 * sx + 5]); pw.w = pk2(s[8 * sx + 6], s[8 * sx + 7]);
            const bf16x8 pf = __builtin_bit_cast(bf16x8, pw); const int jo = 32 * jb + 16 * sx + 4 * hi;
            { const s16x4 lo = *(const LAS s16x4*)(VT + l32 * R_TS + jo), hh = *(const LAS s16x4*)(VT + l32 * R_TS + jo + 8);
              const bf16x8 a = {lo[0], lo[1], lo[2], lo[3], hh[0], hh[1], hh[2], hh[3]}; o0 = __builtin_amdgcn_mfma_f32_32x32x16_bf16(a, pf, o0, 0, 0, 0); }
            { const s16x4 lo = *(const LAS s16x4*)(VT + (32 + l32) * R_TS + jo), hh = *(const LAS s16x4*)(VT + (32 + l32) * R_TS + jo + 8);
              const bf16x8 a = {lo[0], lo[1], lo[2], lo[3], hh[0], hh[1], hh[2], hh[3]}; o1 = __builtin_amdgcn_mfma_f32_32x32x16_bf16(a, pf, o1, 0, 0, 0); } }
    }
#pragma unroll
    for (int ks = 0; ks < 4; ++ks) { const bf16x8 a0 = *(const LAS bf16x8*)(SpT + l32 * R_KS + 16 * ks + 8 * hi), a1 = *(const LAS bf16x8*)(SpT + (32 + l32) * R_KS + 16 * ks + 8 * hi);
        o0 = __builtin_amdgcn_mfma_f32_32x32x16_bf16(a0, qf[ks], o0, 0, 0, 0); o1 = __builtin_amdgcn_mfma_f32_32x32x16_bf16(a1, qf[ks], o1, 0, 0, 0); }
    float sm = 0.f;
#pragma unroll
    for (int r = 0; r < 16; ++r) sm += o0[r] + o1[r];
    sm += __shfl_xor(sm, 32); const float mean = sm * (1.f / 64.f); float sq = 0.f;
#pragma unroll
    for (int r = 0; r < 16; ++r) { const float d0 = o0[r] - mean, d1 = o1[r] - mean; sq += d0 * d0 + d1 * d1; }
    sq += __shfl_xor(sq, 32); const float rstd = 1.0f / sqrtf(sq * (1.f / 64.f) + EPS);
    const size_t row = R0 + 32 * w + l32;
#pragma unroll
    for (int blk = 0; blk < 2; ++blk)
#pragma unroll
        for (int g = 0; g < 4; ++g) { const int dv = 32 * blk + 8 * g + 4 * hi; const size_t off = row * WA + h * 64 + dv;
            const uint2 z = *(const uint2*)(SZR + off); const f32x4 gr = *(const f32x4*)(F.g_ret + h * 64 + dv);
            const float v0 = ((blk ? o1[4 * g + 0] : o0[4 * g + 0]) - mean) * rstd * gr[0] * pg8::bf_lo(z.x), v1 = ((blk ? o1[4 * g + 1] : o0[4 * g + 1]) - mean) * rstd * gr[1] * pg8::bf_hi(z.x);
            const float v2 = ((blk ? o1[4 * g + 2] : o0[4 * g + 2]) - mean) * rstd * gr[2] * pg8::bf_lo(z.y), v3 = ((blk ? o1[4 * g + 3] : o0[4 * g + 3]) - mean) * rstd * gr[3] * pg8::bf_hi(z.y);
            uint2 ow; ow.x = pk2(v0, v1); ow.y = pk2(v2, v3); *(uint2*)(YR + off) = ow; }
    __syncthreads();
}
__device__ __forceinline__ void ret_sample_unit(Frame& F, int db, int h, LAS float* scr) {
    const bf16* QR = (const bf16*)(F.ws + WS_QR); const bf16* KR = (const bf16*)(F.ws + WS_KR); const bf16* VR = (const bf16*)(F.ws + WS_VR); const bf16* SZR = (const bf16*)(F.ws + WS_SZR);
    bf16* YR = (bf16*)(F.ws + WS_YR); const int lane = F.lane; const float lg = l2gamma(h);
    float q[4], k[4], v[4];
#pragma unroll
    for (int t = 0; t < 4; ++t) { const size_t off = (size_t)(MP + 4 * db + t) * WA + h * 64 + lane;
        q[t] = __uint_as_float((unsigned)QR[off] << 16); k[t] = __uint_as_float((unsigned)KR[off] << 16); v[t] = __uint_as_float((unsigned)VR[off] << 16);
        scr[t * 64 + lane] = q[t]; scr[256 + t * 64 + lane] = k[t]; }
    LDS_WAIT(); asm volatile("" ::: "memory");
    const float g1 = __builtin_amdgcn_exp2f(lg), g2 = g1 * g1, g3 = g2 * g1, g4 = g2 * g2;
    const float* S = F.state_ret + ((size_t)(db * NH + h) << 12); float* So = F.out + O_RSS + ((size_t)(db * NH + h) << 12);
    float qs[4] = {0.f, 0.f, 0.f, 0.f};
#pragma unroll 4
    for (int d = 0; d < 64; ++d) { const float s = S[d * 64 + lane];
        qs[0] += scr[d] * s; qs[1] += scr[64 + d] * s; qs[2] += scr[128 + d] * s; qs[3] += scr[192 + d] * s;
        So[d * 64 + lane] = g4 * s + (g3 * scr[256 + d] * v[0] + g2 * scr[320 + d] * v[1]) + (g1 * scr[384 + d] * v[2] + scr[448 + d] * v[3]); }
    const float gp[4] = {1.f, g1, g2, g3};
#pragma unroll
    for (int i = 0; i < 4; ++i) { float o = gp[i] * g1 * qs[i];
#pragma unroll
        for (int j = 0; j <= i; ++j) { const float dot = wave_sum(q[i] * k[j]); o += gp[i - j] * dot * v[j]; }
        const float mean = wave_sum(o) * (1.f / 64.f); const float dd = o - mean; const float rstd = 1.0f / sqrtf(wave_sum(dd * dd) * (1.f / 64.f) + EPS);
        const size_t off = (size_t)(MP + 4 * db + i) * WA + h * 64 + lane;
        YR[off] = (bf16)f2bf(dd * rstd * F.g_ret[h * 64 + lane] * __uint_as_float((unsigned)SZR[off] << 16)); }
    LDS_WAIT(); asm volatile("" ::: "memory");
}
constexpr int IX_BUF = 0, IX_BITS = 65536, IX_HIST = 81920, IX_CNT = 90112, IX_TAU = 90176, IX_CAP = 1024, IX_TRIG = 768;
__device__ __forceinline__ unsigned wave_min_u(unsigned v) {
#pragma unroll
    for (int o = 1; o < 64; o <<= 1) { const unsigned t = (unsigned)__shfl_xor((int)v, o); v = t < v ? t : v; }
    return v; }
__device__ __forceinline__ unsigned wave_max_u(unsigned v) {
#pragma unroll
    for (int o = 1; o < 64; o <<= 1) { const unsigned t = (unsigned)__shfl_xor((int)v, o); v = t > v ? t : v; }
    return v; }
template <int NE> __device__ __forceinline__ unsigned ix_select(LAS unsigned* hist, const unsigned (&e)[NE], int n, int need, int lane) {
    unsigned mn = ~0u, mx = 0u;
#pragma unroll
    for (int i = 0; i < NE; ++i) if (lane + 64 * i < n) { mn = e[i] < mn ? e[i] : mn; mx = e[i] > mx ? e[i] : mx; }
    unsigned lo = wave_min_u(mn), hi = wave_max_u(mx);
    for (int iter = 0; iter < 8; ++iter) {
        const unsigned range = hi - lo;
        if (range == 0u) return lo;
        int sh = 24 - (int)__builtin_clz(range); sh = sh < 0 ? 0 : sh;
        *(LAS v4u*)(hist + 4 * lane) = (v4u){0u, 0u, 0u, 0u};
        LDS_WAIT(); asm volatile("" ::: "memory");
#pragma unroll
        for (int i = 0; i < NE; ++i) if (lane + 64 * i < n && e[i] >= lo && e[i] <= hi) (void)__hip_atomic_fetch_add(hist + ((e[i] - lo) >> sh), 1u, __ATOMIC_RELAXED, __HIP_MEMORY_SCOPE_WORKGROUP);
        LDS_WAIT(); asm volatile("" ::: "memory");
        const v4u h4 = *(const LAS v4u*)(hist + 4 * lane);
        const unsigned sl = h4.x + h4.y + h4.z + h4.w; unsigned incl = sl;
#pragma unroll
        for (int o = 1; o < 64; o <<= 1) { const unsigned t = (unsigned)__shfl_down((int)incl, o); if (lane + o < 64) incl += t; }
        const unsigned excl = incl - sl; const bool here = excl < (unsigned)need && (unsigned)need <= incl;
        unsigned d = 0, above = 0, cd = 0;
        { unsigned c = excl; bool fnd = false;
          if (!fnd) { if (c + h4.w >= (unsigned)need) { d = 4 * lane + 3; above = c; cd = h4.w; fnd = true; } else c += h4.w; }
          if (!fnd) { if (c + h4.z >= (unsigned)need) { d = 4 * lane + 2; above = c; cd = h4.z; fnd = true; } else c += h4.z; }
          if (!fnd) { if (c + h4.y >= (unsigned)need) { d = 4 * lane + 1; above = c; cd = h4.y; fnd = true; } else c += h4.y; }
          if (!fnd) { d = 4 * lane; above = c; cd = h4.x; } }
        const unsigned long long bm = __ballot(here); const int L = bm ? (int)__builtin_ctzll(bm) : 0;
        d = (unsigned)__shfl((int)d, L); above = (unsigned)__shfl((int)above, L); cd = (unsigned)__shfl((int)cd, L);
        need -= (int)above;
        const unsigned lo2 = lo + (d << sh); unsigned top = lo2 + ((1u << sh) - 1u); if (top < lo2) top = ~0u;
        if ((int)cd == need) return lo2;
        lo = lo2; hi = top < hi ? top : hi;
    }
    return lo;
}
__device__ __forceinline__ unsigned ix_entry(float s, int key) {
    unsigned b = __float_as_uint(s); b = (b == 0x80000000u) ? 0u : b;
    const unsigned ok = b ^ ((unsigned)((int)b >> 31) | 0x80000000u);
    return (ok & ~8191u) | (unsigned)(8191 - key);
}
__device__ __forceinline__ void index_unit(Frame& F, int b, int qb) {
    const bf16* QI = (const bf16*)(F.ws + WS_QI); const bf16* KI = (const bf16*)(F.ws + WS_KI); const float* WI = (const float*)(F.ws + WS_WI);
    unsigned long long* MASK = (unsigned long long*)(F.ws + WS_MASK);
    LAS unsigned* BUF = (LAS unsigned*)(F.lds + RING_OFF + IX_BUF); LAS unsigned* BITS = (LAS unsigned*)(F.lds + RING_OFF + IX_BITS);
    LAS unsigned* HIST = (LAS unsigned*)(F.lds + RING_OFF + IX_HIST) + F.wave * 256; LAS unsigned* CNT = (LAS unsigned*)(F.lds + RING_OFF + IX_CNT); LAS unsigned* TAU = (LAS unsigned*)(F.lds + RING_OFF + IX_TAU);
    const int tid = F.tid, lane = F.lane, w = F.wave, l32 = lane & 31, hi = lane >> 5;
    const int p0 = 16 * qb; const size_t R0 = (size_t)b * SEQ + p0;
    const int nt = ((p0 + 15) >> 5) + 1, rounds = (nt + 7) >> 3;
    if (tid < 32) CNT[tid] = 0u;
    for (int i = tid; i < 16 * 256; i += 512) BITS[i] = 0u;
    bf16x8 af[2][4]; f32x4 wv[2][4];
#pragma unroll
    for (int rb = 0; rb < 2; ++rb) {
#pragma unroll
        for (int ks = 0; ks < 4; ++ks) af[rb][ks] = *(const bf16x8*)(QI + (R0 + rb * 8 + (l32 >> 2)) * 256 + (l32 & 3) * 64 + 16 * ks + 8 * hi);
#pragma unroll
        for (int g = 0; g < 4; ++g) wv[rb][g] = *(const f32x4*)(WI + (R0 + rb * 8 + 2 * g + hi) * 4); }
    __syncthreads();
    for (int rd = 0; rd < rounds; ++rd) {
        const int tile = 8 * rd + w;
        if (tile < nt) {
            const int key = 32 * tile + l32; const bf16* kp = KI + ((size_t)b * SEQ + key) * 64 + 8 * hi;
            bf16x8 bq[4];
#pragma unroll
            for (int ks = 0; ks < 4; ++ks) bq[ks] = *(const bf16x8*)(kp + 16 * ks);
            f32x16 a0 = {}, a1 = {};
#pragma unroll
            for (int ks = 0; ks < 4; ++ks) { a0 = __builtin_amdgcn_mfma_f32_32x32x16_bf16(af[0][ks], bq[ks], a0, 0, 0, 0); a1 = __builtin_amdgcn_mfma_f32_32x32x16_bf16(af[1][ks], bq[ks], a1, 0, 0, 0); }
            const bool diag = (32 * tile + 31 > p0);
#pragma unroll
            for (int rb = 0; rb < 2; ++rb)
#pragma unroll
                for (int g = 0; g < 4; ++g) { const int q = rb * 8 + 2 * g + hi; const f32x4 wq = wv[rb][g];
                    const float x0 = rb ? a1[4 * g] : a0[4 * g], x1 = rb ? a1[4 * g + 1] : a0[4 * g + 1], x2 = rb ? a1[4 * g + 2] : a0[4 * g + 2], x3 = rb ? a1[4 * g + 3] : a0[4 * g + 3];
                    float s = wq[0] * fmaxf(x0, 0.f); s = __builtin_fmaf(wq[1], fmaxf(x1, 0.f), s); s = __builtin_fmaf(wq[2], fmaxf(x2, 0.f), s); s = __builtin_fmaf(wq[3], fmaxf(x3, 0.f), s);
                    const unsigned ent = ix_entry(s, key);
                    if (ent > TAU[q] && (!diag || key <= p0 + q)) { const unsigned slot = __hip_atomic_fetch_add(CNT + q, 1u, __ATOMIC_RELAXED, __HIP_MEMORY_SCOPE_WORKGROUP); if (slot < (unsigned)IX_CAP) BUF[q * IX_CAP + slot] = ent; } }
        }
        __syncthreads();
#pragma unroll 1
        for (int qq = 2 * w; qq < 2 * w + 2; ++qq) { int n = (int)CNT[qq]; n = n > IX_CAP ? IX_CAP : n;
            if (n > IX_TRIG) { unsigned e[16];
#pragma unroll
                for (int i = 0; i < 16; ++i) e[i] = (lane + 64 * i < n) ? BUF[qq * IX_CAP + lane + 64 * i] : 0u;
                const unsigned T = ix_select<16>(HIST, e, n, TOPK, lane);
                int base = 0;
#pragma unroll
                for (int i = 0; i < 16; ++i) { const bool keep = (lane + 64 * i < n) && e[i] >= T; const unsigned long long m = __ballot(keep);
                    if (keep) BUF[qq * IX_CAP + base + __builtin_popcountll(m & ((1ull << lane) - 1ull))] = e[i]; base += __builtin_popcountll(m); }
                if (lane == 0) { CNT[qq] = (unsigned)base; TAU[qq] = T; } } }
        __syncthreads();
    }
#pragma unroll 1
    for (int qq = 2 * w; qq < 2 * w + 2; ++qq) { int n = (int)CNT[qq]; n = n > IX_CAP ? IX_CAP : n; unsigned e[16];
#pragma unroll
        for (int i = 0; i < 16; ++i) e[i] = (lane + 64 * i < n) ? BUF[qq * IX_CAP + lane + 64 * i] : 0u;
        unsigned T = 0u; if (n > TOPK) T = ix_select<16>(HIST, e, n, TOPK, lane);
#pragma unroll
        for (int i = 0; i < 16; ++i) if ((lane + 64 * i < n) && e[i] >= T) { const unsigned idx = 8191u - (e[i] & 8191u); (void)__hip_atomic_fetch_or(BITS + qq * 256 + (idx >> 5), 1u << (idx & 31), __ATOMIC_RELAXED, __HIP_MEMORY_SCOPE_WORKGROUP); } }
    __syncthreads();
    {   const int ntm = 4 * ((p0 >> 8) + 1), q = tid & 15;
        for (int t = tid >> 4; t < ntm; t += 32) { const unsigned lo = BITS[q * 256 + 2 * t], hh = BITS[q * 256 + 2 * t + 1];
            MASK[((size_t)(b * 128 + t) << 13) + p0 + q] = (unsigned long long)lo | ((unsigned long long)hh << 32); } }
    __syncthreads();
}
typedef float f32x4v __attribute__((ext_vector_type(4)));
__device__ __forceinline__ void sscore_unit(Frame& F, int db, int ch) {
    const bf16* QI = (const bf16*)(F.ws + WS_QI); const bf16* KI = (const bf16*)(F.ws + WS_KI); const float* WI = (const float*)(F.ws + WS_WI); float* SSC = (float*)(F.ws + WS_SSC);
    const int lane = F.lane, w = F.wave, c16 = lane & 15, kq = lane >> 4;
    bf16x8 af[2];
#pragma unroll
    for (int ks = 0; ks < 2; ++ks) af[ks] = *(const bf16x8*)(QI + (size_t)(MP + 4 * db + (c16 >> 2)) * 256 + (c16 & 3) * 64 + 32 * ks + 8 * kq);
    const f32x4 wq = *(const f32x4*)(WI + (size_t)(MP + 4 * db + kq) * 4);
    float* srow = SSC + (size_t)(4 * db + kq) * SSC_LD;
#pragma unroll 2
    for (int tl = 0; tl < 8; ++tl) { const int key = 1024 * ch + 128 * w + 16 * tl + c16;
        const int phys = F.page_table[db * NPAGES + (key >> 7)]; const float* kp = F.cache_ki + ((size_t)phys * PAGE + (key & 127)) * HDI + 8 * kq;
        f32x4 acc = {0.f, 0.f, 0.f, 0.f};
#pragma unroll
        for (int ks = 0; ks < 2; ++ks) { const f32x4 k0 = *(const f32x4*)(kp + 32 * ks), k1 = *(const f32x4*)(kp + 32 * ks + 4);
            v4u kw; kw.x = pk2(k0[0], k0[1]); kw.y = pk2(k0[2], k0[3]); kw.z = pk2(k1[0], k1[1]); kw.w = pk2(k1[2], k1[3]);
            acc = __builtin_amdgcn_mfma_f32_16x16x32_bf16(af[ks], __builtin_bit_cast(bf16x8, kw), acc, 0, 0, 0); }
        float s = wq[0] * fmaxf(acc[0], 0.f); s = __builtin_fmaf(wq[1], fmaxf(acc[1], 0.f), s); s = __builtin_fmaf(wq[2], fmaxf(acc[2], 0.f), s); s = __builtin_fmaf(wq[3], fmaxf(acc[3], 0.f), s);
        srow[key] = s; }
    if (ch == 7 && w == 0) {
        f32x4 acc = {0.f, 0.f, 0.f, 0.f};
#pragma unroll
        for (int ks = 0; ks < 2; ++ks) { bf16x8 bq = {0, 0, 0, 0, 0, 0, 0, 0}; if (c16 < 4) bq = *(const bf16x8*)(KI + (size_t)(MP + 4 * db + c16) * HDI + 32 * ks + 8 * kq);
            acc = __builtin_amdgcn_mfma_f32_16x16x32_bf16(af[ks], bq, acc, 0, 0, 0); }
        float s = wq[0] * fmaxf(acc[0], 0.f); s = __builtin_fmaf(wq[1], fmaxf(acc[1], 0.f), s); s = __builtin_fmaf(wq[2], fmaxf(acc[2], 0.f), s); s = __builtin_fmaf(wq[3], fmaxf(acc[3], 0.f), s);
        if (c16 < 4) srow[PAST + c16] = s; }
}
constexpr int SA_SC = 0, SA_SEL = 33792, SA_RB = 34816, SA_HIST = 35840, SA_LG = 36864  , SA_MISC = 45056;
__device__ __forceinline__ unsigned sa_select(LAS unsigned* hist, const LAS unsigned* keys, int n, int need, int lane) {
    unsigned mn = ~0u, mx = 0u;
    for (int i = lane; i < n; i += 64) { const unsigned e = keys[i]; mn = e < mn ? e : mn; mx = e > mx ? e : mx; }
    unsigned lo = wave_min_u(mn), hi = wave_max_u(mx);
    for (int iter = 0; iter < 8; ++iter) {
        const unsigned range = hi - lo;
        if (range == 0u) return lo;
        int sh = 24 - (int)__builtin_clz(range); sh = sh < 0 ? 0 : sh;
        *(LAS v4u*)(hist + 4 * lane) = (v4u){0u, 0u, 0u, 0u};
        LDS_WAIT(); asm volatile("" ::: "memory");
        for (int i = lane; i < n; i += 64) { const unsigned e = keys[i]; if (e >= lo && e <= hi) (void)__hip_atomic_fetch_add(hist + ((e - lo) >> sh), 1u, __ATOMIC_RELAXED, __HIP_MEMORY_SCOPE_WORKGROUP); }
        LDS_WAIT(); asm volatile("" ::: "memory");
        const v4u h4 = *(const LAS v4u*)(hist + 4 * lane);
        const unsigned sl = h4.x + h4.y + h4.z + h4.w; unsigned incl = sl;
#pragma unroll
        for (int o = 1; o < 64; o <<= 1) { const unsigned t = (unsigned)__shfl_down((int)incl, o); if (lane + o < 64) incl += t; }
        const unsigned excl = incl - sl; const bool here = excl < (unsigned)need && (unsigned)need <= incl;
        unsigned d = 0, above = 0, cd = 0;
        { unsigned c = excl; bool fnd = false;
          if (!fnd) { if (c + h4.w >= (unsigned)need) { d = 4 * lane + 3; above = c; cd = h4.w; fnd = true; } else c += h4.w; }
          if (!fnd) { if (c + h4.z >= (unsigned)need) { d = 4 * lane + 2; above = c; cd = h4.z; fnd = true; } else c += h4.z; }
          if (!fnd) { if (c + h4.y >= (unsigned)need) { d = 4 * lane + 1; above = c; cd = h4.y; fnd = true; } else c += h4.y; }
          if (!fnd) { d = 4 * lane; above = c; cd = h4.x; } }
        const unsigned long long bm = __ballot(here); const int L = bm ? (int)__builtin_ctzll(bm) : 0;
        d = (unsigned)__shfl((int)d, L); above = (unsigned)__shfl((int)above, L); cd = (unsigned)__shfl((int)cd, L);
        need -= (int)above;
        const unsigned lo2 = lo + (d << sh); unsigned top = lo2 + ((1u << sh) - 1u); if (top < lo2) top = ~0u;
        if ((int)cd == need) return lo2;
        lo = lo2; hi = top < hi ? top : hi;
    }
    return lo;
}
__device__ __forceinline__ unsigned okey_f(float s) { unsigned b = __float_as_uint(s); b = (b == 0x80000000u) ? 0u : b; return b ^ ((unsigned)((int)b >> 31) | 0x80000000u); }
__device__ __forceinline__ void sattn_unit(Frame& F, int sq) {
    const int db = sq >> 2, t = sq & 3, n = PAST + t + 1; const int tid = F.tid, lane = F.lane, h = F.wave;
    const float* SSC = (const float*)(F.ws + WS_SSC) + (size_t)sq * SSC_LD; const bf16* QA = (const bf16*)(F.ws + WS_QA); const bf16* SZA = (const bf16*)(F.ws + WS_SZA); bf16* YA = (bf16*)(F.ws + WS_YA);
    LAS unsigned* SC = (LAS unsigned*)(F.lds + RING_OFF + SA_SC); LAS unsigned* SEL = (LAS unsigned*)(F.lds + RING_OFF + SA_SEL); LAS unsigned* RB = (LAS unsigned*)(F.lds + RING_OFF + SA_RB);
    LAS unsigned* HIST = (LAS unsigned*)(F.lds + RING_OFF + SA_HIST); LAS float* LG = (LAS float*)(F.lds + RING_OFF + SA_LG) + h * 256;
    for (int i = tid; i < n; i += 512) SC[i] = okey_f(SSC[i]);
    __syncthreads();
    if (h == 0) {
        const unsigned T = sa_select(HIST, SC, n, TOPK, lane);
        int cgt = 0; for (int i = lane; i < n; i += 64) cgt += SC[i] > T ? 1 : 0;
        cgt = (int)wave_sum((float)cgt);
        int need_eq = TOPK - cgt, base = 0;
        for (int i0 = 0; i0 < n; i0 += 64) { const int i = i0 + lane; const unsigned e = i < n ? SC[i] : 0u; const bool gt = i < n && e > T; bool eq = i < n && e == T;
            const unsigned long long me = __ballot(eq); const int pe = __builtin_popcountll(me & ((1ull << lane) - 1ull)); eq = eq && pe < need_eq;
            const int taken = __builtin_popcountll(me); need_eq -= taken < need_eq ? taken : need_eq;
            const bool tk = gt || eq; const unsigned long long mt = __ballot(tk);
            if (tk) SEL[base + __builtin_popcountll(mt & ((1ull << lane) - 1ull))] = (unsigned)i; base += __builtin_popcountll(mt); }
    }
    __syncthreads();
    if (tid < TOPK) { const unsigned idx = SEL[tid]; RB[tid] = idx < (unsigned)PAST ? (unsigned)F.page_table[db * NPAGES + (idx >> 7)] * PAGE + (idx & 127u) : (0x80000000u | (idx - PAST)); }
    __syncthreads();
    const int jg = lane >> 4, dc = lane & 15; const size_t qrow = (size_t)(MP + sq) * WA + h * 64 + 4 * dc;
    float q4[4]; { const uint2 qw = *(const uint2*)(QA + qrow); q4[0] = pg8::bf_lo(qw.x); q4[1] = pg8::bf_hi(qw.x); q4[2] = pg8::bf_lo(qw.y); q4[3] = pg8::bf_hi(qw.y); }
    const float* knew = F.out + O_KS + (size_t)(db * 4) * WA + h * 64 + 4 * dc; const float* vnew = F.out + O_VS + (size_t)(db * 4) * WA + h * 64 + 4 * dc;
#pragma unroll 8
    for (int it = 0; it < 64; ++it) { const int j = 4 * it + jg; const unsigned rb = RB[j];
        const float* kp = (rb & 0x80000000u) ? knew + (size_t)(rb & 3u) * WA : F.cache_k + ((size_t)rb * NH + h) * 64 + 4 * dc;
        const f32x4 k4 = *(const f32x4*)kp; float d = (q4[0] * k4[0] + q4[1] * k4[1]) + (q4[2] * k4[2] + q4[3] * k4[3]);
        d += __shfl_xor(d, 1); d += __shfl_xor(d, 2); d += __shfl_xor(d, 4); d += __shfl_xor(d, 8);
        if (dc == 0) LG[j] = d; }
    LDS_WAIT(); asm volatile("" ::: "memory");
    float lv[4], mx = -INFINITY;
#pragma unroll
    for (int i = 0; i < 4; ++i) { lv[i] = LG[lane + 64 * i]; mx = fmaxf(mx, lv[i]); }
#pragma unroll
    for (int o = 1; o < 64; o <<= 1) mx = fmaxf(mx, __shfl_xor(mx, o));
    float sm = 0.f;
#pragma unroll
    for (int i = 0; i < 4; ++i) { lv[i] = __builtin_amdgcn_exp2f(lv[i] - mx); sm += lv[i]; }
    sm = wave_sum(sm);
#pragma unroll
    for (int i = 0; i < 4; ++i) LG[lane + 64 * i] = lv[i];
    LDS_WAIT(); asm volatile("" ::: "memory");
    f32x4 o4 = {0.f, 0.f, 0.f, 0.f};
#pragma unroll 8
    for (int it = 0; it < 64; ++it) { const int j = 4 * it + jg; const unsigned rb = RB[j]; const float p = LG[j];
        const float* vp = (rb & 0x80000000u) ? vnew + (size_t)(rb & 3u) * WA : F.cache_v + ((size_t)rb * NH + h) * 64 + 4 * dc;
        o4 += *(const f32x4*)vp * p; }
#pragma unroll
    for (int e = 0; e < 4; ++e) { o4[e] += __shfl_xor(o4[e], 16); o4[e] += __shfl_xor(o4[e], 32); }
    if (jg == 0) { const float rl = 1.0f / sm; const uint2 z = *(const uint2*)(SZA + qrow);
        uint2 y; y.x = pk2(o4[0] * rl * pg8::bf_lo(z.x), o4[1] * rl * pg8::bf_hi(z.x)); y.y = pk2(o4[2] * rl * pg8::bf_lo(z.y), o4[3] * rl * pg8::bf_hi(z.y));
        *(uint2*)(YA + qrow) = y; }
    __syncthreads();
}
#define P3_BODY \
    if (F.G == 256) { for (int i = 0; i < 4; ++i) { const int k = (i == 0) ? F.vcu : (i == 1) ? 1023 - F.vcu : (i == 2) ? 256 + F.vcu : 767 - F.vcu; index_unit(F, k & 1, k >> 1); } } \
    else { for (int k = F.vcu; k < 1024; k += F.G) index_unit(F, k & 1, k >> 1); } \
    for (int u = F.vcu; u < DB * 8; u += F.G) sscore_unit(F, u >> 3, u & 7); \
    for (int u = F.vcu; u < NB * NH * NCH; u += F.G) ret_local_unit(F, u / (NH * NCH), (u / NCH) % NH, u % NCH); \
    if (F.wave == 0) { for (int u = F.vcu; u < DB * NH; u += F.G) ret_sample_unit(F, u / NH, u % NH, (LAS float*)(F.lds + RING_OFF)); } \
    __syncthreads();
#define P4_BODY \
    for (int u = F.vcu; u < MS; u += F.G) sattn_unit(F, u); \
    { const attn_body::AttnTensors AT{(const attn_body::bf16*)QA, (const attn_body::bf16*)KA, (const attn_body::bf16*)VA, (attn_body::bf16*)YA, (const unsigned long long*)(ws + WS_MASK), (const attn_body::bf16*)SZA}; \
      const attn_body::StaticOrder S((int)F.G, (int)blockIdx.x); attn_body::attn_phase<attn_body::StaticOrder>((char*)lds + RING_OFF, AT, S); } \
    for (int u = F.vcu; u < NB * NH * NCH; u += F.G) ret_out_unit(F, u / (NH * NCH), (u / NCH) % NH, u % NCH);
struct Args { const void* in[18]; float* out; unsigned char* ws; int ph_lo, ph_hi, li, pad; };
__global__ void __launch_bounds__(NWAVES * 64, 2) hybrid_fwd(Args args) {
    extern __shared__ __attribute__((aligned(16))) unsigned char lds[];
    Frame F;
    F.lds = (LAS unsigned char*)lds;
    F.MISC = (volatile LAS unsigned*)(F.lds + MISC_OFF);
    F.tid = threadIdx.x; F.lane = F.tid & 63; F.wave = __builtin_amdgcn_readfirstlane(F.tid >> 6);
    F.G = gridDim.x; { const int bx = blockIdx.x; F.vcu = (F.G % 8 == 0) ? (bx % 8) * (F.G / 8) + bx / 8 : bx; }
#define GRID_BAR(seam) do { if (N_LAUNCHES == N_PHASES) { if (F.tid == 0) __hip_atomic_store(F.ctl + CW_TMO, 0xBADBA0u | (unsigned)(seam), RLX_AGENT); } else { xcd_barrier(bar); } } while (0)
    unsigned char* ws = args.ws; F.ws = ws;
    F.ctl = (gu32*)(ws + WS_CTL);
    F.x_p = (const float*)args.in[0]; F.x_s = (const float*)args.in[1]; F.cache_k = (const float*)args.in[2]; F.cache_v = (const float*)args.in[3]; F.cache_ki = (const float*)args.in[4];
    F.state_ret = (const float*)args.in[5]; F.page_table = (const int*)args.in[6]; F.c_p = (const float*)args.in[7]; F.c_s = (const float*)args.in[8]; F.w_ada = (const float*)args.in[9];
    F.b_ada = (const float*)args.in[10]; F.g_norm = (const float*)args.in[11]; F.w_in = (const float*)args.in[12]; F.g_ret = (const float*)args.in[13]; F.w_pa = (const float*)args.in[14];
    F.w_pr = (const float*)args.in[15]; F.w_out = (const float*)args.in[16]; F.g_final = (const float*)args.in[17]; F.out = args.out;
    for (int u = F.tid; u < (LDS_BYTES - LDSCTL_OFF) / 4; u += NWAVES * 64) ((LAS unsigned*)(F.lds + LDSCTL_OFF))[u] = 0u;
    __syncthreads();
    XcdBarrier bar; bar.bar = (unsigned*)(F.ctl + CW_BAR); bar.x = 0; bar.st = nullptr;
    if (N_LAUNCHES != N_PHASES) bar = xcd_barrier_post((unsigned*)(F.ctl + CW_BAR), F.MISC + 8);
    const int lo = args.ph_lo, hi = args.ph_hi;
#define IN(k) (lo <= (k) && (k) < hi)
#define BOTH(k) (IN(k) && IN((k) + 1))
    bf16* const H = (bf16*)(ws + WS_H);
    bf16* const QA = (bf16*)(ws + WS_QA); bf16* const KA = (bf16*)(ws + WS_KA); bf16* const VA = (bf16*)(ws + WS_VA); bf16* const SZA = (bf16*)(ws + WS_SZA);
    bf16* const QI = (bf16*)(ws + WS_QI); bf16* const KI = (bf16*)(ws + WS_KI); float* const WI = (float*)(ws + WS_WI);
    bf16* const QR = (bf16*)(ws + WS_QR); bf16* const KR = (bf16*)(ws + WS_KR); bf16* const VR = (bf16*)(ws + WS_VR); bf16* const SZR = (bf16*)(ws + WS_SZR);
    bf16* const SGA = (bf16*)(ws + WS_SGA); bf16* const SGR = (bf16*)(ws + WS_SGR); bf16* const YA = (bf16*)(ws + WS_YA); bf16* const YR = (bf16*)(ws + WS_YR);
    bf16* const T1 = (bf16*)(ws + WS_T1); bf16* const MG = (bf16*)(ws + WS_MG);

    if (IN(0)) { p0_prologue(F); if (BOTH(0)) GRID_BAR(0); }
    if (IN(1)) { p1_hrows(F); if (BOTH(1)) GRID_BAR(1); }
    if (IN(2)) {
        pg8::Gemm g{H, (const bf16*)(ws + WS_WIN), MT, NINP, D}; pg8::StaticOrder S; S.init(MT, NINP, F.G, (int)blockIdx.x);
        pg8::EpiIn E{QA, KA, VA, SZA, QI, KI, QR, KR, VR, SZR, SGA, SGR, WI, (const float*)(ws + WS_ROPE), F.out};
        pg8::gemm_phase<pg8::EpiIn, pg8::StaticOrder, true, true>(F.lds + RING_OFF, g, S, E);
        if (BOTH(2)) GRID_BAR(2);
    }
    if (IN(3)) {
        P3_BODY
        if (BOTH(3)) GRID_BAR(3);
    }
    if (IN(4)) {
        P4_BODY
        if (BOTH(4)) GRID_BAR(4);
    }
    if (IN(5)) {
        pg8::Gemm g{YA, (const bf16*)(ws + WS_WPA), MT, D, WA}; pg8::StaticOrder S; S.init(MT, D, F.G, (int)blockIdx.x);
        pg8::EpiGate<0> E{SGA, nullptr, T1};
        pg8::gemm_phase<pg8::EpiGate<0>, pg8::StaticOrder, true, true>(F.lds + RING_OFF, g, S, E);
        if (BOTH(5)) GRID_BAR(5);
    }
    if (IN(6)) {
        pg8::Gemm g{YR, (const bf16*)(ws + WS_WPR), MT, D, WA}; pg8::StaticOrder S; S.init(MT, D, F.G, (int)blockIdx.x);
        pg8::EpiGate<1> E{SGR, T1, MG};
        pg8::gemm_phase<pg8::EpiGate<1>, pg8::StaticOrder, true, true>(F.lds + RING_OFF, g, S, E);
        if (BOTH(6)) GRID_BAR(6);
    }
    if (IN(7)) {
        pg8::Gemm g{MG, (const bf16*)(ws + WS_WOUT), MT, D, D}; pg8::StaticOrder S; S.init(MT, D, F.G, (int)blockIdx.x);
        pg8::EpiOut E{F.x_p, F.x_s, (const float*)(F.ctl + CW_MOD), F.b_ada, F.out};
        pg8::gemm_phase<pg8::EpiOut, pg8::StaticOrder, true, true>(F.lds + RING_OFF, g, S, E);
        if (BOTH(7)) GRID_BAR(7);
    }
    if (IN(8)) { p8_final(F); }
#undef IN
#undef BOTH
}

extern "C" void kernel_launch(void* const* d_in, const int* in_sizes, int n_in, void* d_out, int out_size, void* d_ws, size_t ws_size, hipStream_t stream) {
    static int grid = 0;
    if (grid == 0) {
        if (n_in != 18 || out_size != (int)O_END || ws_size < WS_END) { fprintf(stderr, "kernel_launch: unexpected shapes (n_in %d, out %d, ws %zu); nothing launched\n", n_in, out_size, ws_size); grid = -1; return; }
        int dev = 0, cus = 0, per_cu = 0;
        if (hipGetDevice(&dev) != hipSuccess || hipDeviceGetAttribute(&cus, hipDeviceAttributeMultiprocessorCount, dev) != hipSuccess) { grid = -1; return; }
        if (hipFuncSetAttribute((const void*)hybrid_fwd, hipFuncAttributeMaxDynamicSharedMemorySize, LDS_BYTES) != hipSuccess) { fprintf(stderr, "kernel_launch: hipFuncSetAttribute failed\n"); grid = -1; return; }
        if (hipOccupancyMaxActiveBlocksPerMultiprocessor(&per_cu, (const void*)hybrid_fwd, NWAVES * 64, LDS_BYTES) != hipSuccess || per_cu < 1) { fprintf(stderr, "kernel_launch: occupancy query reports %d\n", per_cu); }
        (void)hipGetLastError();
        grid = cus;
    }
    if (grid < 0) return;
    if (hipMemsetAsync((char*)d_ws + WS_CTL, 0, CTL_ZERO_BYTES, stream) != hipSuccess) return;
    Args a{};
    for (int i = 0; i < 18; ++i) a.in[i] = d_in[i];
    a.out = (float*)d_out; a.ws = (unsigned char*)d_ws;
    for (int li = 0; li < N_LAUNCHES; ++li) {
        a.ph_lo = (N_LAUNCHES == N_PHASES) ? li : 0; a.ph_hi = (N_LAUNCHES == N_PHASES) ? li + 1 : N_PHASES; a.li = li;
        hipLaunchKernelGGL(hybrid_fwd, dim3(grid), dim3(NWAVES * 64), LDS_BYTES, stream, a);
        const hipError_t le = hipPeekAtLastError();
        if (le != hipSuccess) { fprintf(stderr, "kernel_launch: launch %d failed: %s\n", li, hipGetErrorName(le)); break; }
    }
}
```

```cpp
#include <hip/hip_runtime.h>
#include <hip/hip_bf16.h>
#include <cstdio>
#include <cstdint>
#include <cmath>
constexpr int D = 1024, SEQ = 8192, NB = 2, DB = 32, DSEQ = 4, PAST = 8192, PAGE = 128, NPAGES = PAST / PAGE;
constexpr int MP = NB * SEQ;
constexpr int MS = DB * DSEQ;
constexpr int MR = MP + MS;
constexpr int MT = 16640;
constexpr int NH = 8, HD = 64, WA = 512, NHI = 4, HDI = 64, TOPK = 256;
constexpr int NIN = 6468, NINP = 6656;
constexpr int NMOD = 2 + DB;
constexpr float EPS = 1e-6f;
constexpr size_t O_YP = 0, O_YS = O_YP + (size_t)MP * D, O_KP = O_YS + (size_t)MS * D, O_VP = O_KP + (size_t)MP * WA, O_KIP = O_VP + (size_t)MP * WA,
                 O_RSP = O_KIP + (size_t)MP * HDI, O_KS = O_RSP + (size_t)NB * NH * 64 * 64, O_VS = O_KS + (size_t)MS * WA, O_KIS = O_VS + (size_t)MS * WA,
                 O_RSS = O_KIS + (size_t)MS * HDI, O_END = O_RSS + (size_t)DB * NH * 64 * 64;
static_assert(O_END == 35987456, "output size");
#ifdef PROBE_TS
#define TS_W_ ((volatile __attribute__((address_space(3))) unsigned*)(F.lds + 131072))
#define TS_DECL() do {} while (0)
#define TS_BEGIN() do { if (threadIdx.x == 0) TS_W_[31] = (unsigned)__builtin_amdgcn_s_memrealtime(); } while (0)
#define TS_ADD(i) do { if (threadIdx.x == 0) { const unsigned n_ = (unsigned)__builtin_amdgcn_s_memrealtime(); TS_W_[i] += n_ - TS_W_[31]; TS_W_[31] = n_; } } while (0)
#else
#define TS_DECL() do {} while (0)
#define TS_BEGIN() do {} while (0)
#define TS_ADD(i) do {} while (0)
#endif
namespace pg8 {
#define PG8_LAS __attribute__((address_space(3)))
typedef unsigned short bf16_t;
typedef short bf16x8 __attribute__((ext_vector_type(8)));
typedef float f32x4 __attribute__((ext_vector_type(4)));
typedef unsigned u32x4 __attribute__((ext_vector_type(4)));
constexpr int BM = 256, BK = 64, HALF = 128, HTB = HALF * BK * 2  , STAGE_BYTES = 8 * HTB, NXCD = 8, WGM = 8;

__host__ __device__ __forceinline__ int lds_byte(int r, int c) { const int st = (r >> 4) * 2 + (c >> 5), rr = r & 15, cc = c & 31, ob = rr * 64 + cc * 2; return st * 1024 + (ob ^ (((ob >> 9) & 1) << 5)); }
__host__ __device__ __forceinline__ void stage_rc(int b, int& R, int& C) { const int st = b / 1024, sb = b % 1024, swz = sb ^ (((sb >> 9) & 1) << 5); R = (st >> 1) * 16 + swz / 64; C = (st & 1) * 32 + (swz % 64) / 2; }
__host__ __device__ __forceinline__ int perm32(int rho) { const int n = rho >> 4, i = rho & 15; return 8 * (i >> 2) + 4 * n + (i & 3); }

struct Unit { int pm, pn; };
struct Gemm { const bf16_t* A; const bf16_t* Bt; int M, N, K; };

struct StaticOrder {
    int nM, nN, nwg, G, c;
    __host__ __device__ void init(int M, int N, int G_, int c_) { nM = M / BM; nN = N / BM; nwg = nM * nN; G = G_; c = c_; }
    __host__ __device__ bool next(int i, Unit& u) const {
        const long L = (long)i * G + c; if (L >= nwg) return false;
        int wgid = (int)L; { const int q = nwg / NXCD, r = nwg % NXCD, xcd = wgid % NXCD, off = wgid / NXCD; wgid = (xcd < r ? xcd * (q + 1) : r * (q + 1) + (xcd - r) * q) + off; }
        const int nig = WGM * nN, gid = wgid / nig, fm = gid * WGM, gsz = (nM - fm) < WGM ? (nM - fm) : WGM;
        u.pm = fm + ((wgid % nig) % gsz); u.pn = (wgid % nig) / gsz; return true;
    }
    __device__ __forceinline__ void a_ready(const Unit&) const {}
    __device__ __forceinline__ void done(const Unit&) const {}
};

__device__ __forceinline__ unsigned cvt_pk_bf16(float lo, float hi) { unsigned r; asm volatile("v_cvt_pk_bf16_f32 %0, %1, %2" : "=v"(r) : "v"(lo), "v"(hi)); return r; }
__device__ __forceinline__ float bf_lo(unsigned w) { return __uint_as_float(w << 16); }
__device__ __forceinline__ float bf_hi(unsigned w) { return __uint_as_float(w & 0xffff0000u); }
__device__ __forceinline__ float sigmoidf_(float x) { return __builtin_amdgcn_rcpf(1.0f + __builtin_amdgcn_exp2f(-1.4426950408889634f * x)); }
__device__ __forceinline__ u32x4 pack8(f32x4 a, f32x4 b) { u32x4 w; w.x = cvt_pk_bf16(a[0], a[1]); w.y = cvt_pk_bf16(a[2], a[3]); w.z = cvt_pk_bf16(b[0], b[1]); w.w = cvt_pk_bf16(b[2], b[3]); return w; }

struct EpiIn {
    static constexpr bool PERM = true, AFTER_DRAIN = false;
    bf16_t *QA, *KA, *VA, *SZA, *QI, *KI, *QR, *KR, *VR, *SZR, *SGA, *SGR; float* WI; const float* rope; float* out; bf16_t* KIT;
    __device__ __forceinline__ void operator()(const f32x4 (&acc)[2][2][4][2], const Unit& u, int wr, int wc, int fr, int fq) const {
        const int pn = u.pn;
        const int rbase = u.pm * BM + wr * 64 + fr;
        const int cl = wc * 32 + 8 * fq;
        const bool smp = (u.pm == MP / BM);
        constexpr float C2 = 0.125f * 1.4426950408889634f;
        if (pn < 8) {
            const int seg = pn >> 1, c0 = (pn & 1) * 256 + cl;
            bf16_t* dst = seg == 0 ? QA : seg == 1 ? KA : seg == 2 ? VA : SZA;
            float* of = nullptr; if (seg == 1) of = out + (smp ? O_KS : O_KP); else if (seg == 2) of = out + (smp ? O_VS : O_VP);
#pragma unroll
            for (int ai = 0; ai < 2; ++ai)
#pragma unroll
                for (int m = 0; m < 4; ++m) { const int row = rbase + ai * HALF + m * 16;
#pragma unroll
                    for (int bj = 0; bj < 2; ++bj) { f32x4 v0 = acc[ai][bj][m][0], v1 = acc[ai][bj][m][1]; const int col = c0 + bj * HALF;
                        if (of && !(smp && ai == 1)) { float* o = of + (size_t)(smp ? row - MP : row) * WA + col; *(f32x4*)o = v0; *(f32x4*)(o + 4) = v1; }
                        if (seg == 0) { v0 = v0 * C2; v1 = v1 * C2; }
                        if (seg == 3) {
#pragma unroll
                            for (int e = 0; e < 4; ++e) { v0[e] = v0[e] * sigmoidf_(v0[e]); v1[e] = v1[e] * sigmoidf_(v1[e]); } }
                        *(u32x4*)(dst + (size_t)row * WA + col) = pack8(v0, v1); } }
        } else if (pn == 8) {
#pragma unroll
            for (int ai = 0; ai < 2; ++ai)
#pragma unroll
                for (int m = 0; m < 4; ++m) { const int row = rbase + ai * HALF + m * 16;
#pragma unroll
                    for (int bj = 0; bj < 2; ++bj) *(u32x4*)(QI + (size_t)row * 256 + bj * HALF + cl) = pack8(acc[ai][bj][m][0], acc[ai][bj][m][1]); }
        } else if (pn == 9) {
            if (wc < 2) {
                float* of = out + (smp ? O_KIS : O_KIP);
#pragma unroll
                for (int ai = 0; ai < 2; ++ai)
#pragma unroll
                    for (int m = 0; m < 4; ++m) { const int row = rbase + ai * HALF + m * 16; const f32x4 v0 = acc[ai][0][m][0], v1 = acc[ai][0][m][1];
                        if (!(smp && ai == 1)) { float* o = of + (size_t)(smp ? row - MP : row) * HDI + cl; *(f32x4*)o = v0; *(f32x4*)(o + 4) = v1; }
                        const u32x4 pk_ = pack8(v0, v1); *(u32x4*)(KI + (size_t)row * HDI + cl) = pk_;
                        *(u32x4*)(KIT + ((((size_t)(row >> 5) * 8 + (cl >> 3)) * 32 + (row & 31)) << 3)) = pk_; }
            } else if (wc == 2 && fq == 0) {
#pragma unroll
                for (int ai = 0; ai < 2; ++ai)
#pragma unroll
                    for (int m = 0; m < 4; ++m) { const int row = rbase + ai * HALF + m * 16; *(f32x4*)(WI + (size_t)row * 4) = acc[ai][0][m][0] * 0.0625f; }
            }
        } else if (pn < 14) {
            const int seg = (pn - 10) >> 1, head = 4 * ((pn - 10) & 1) + wc; bf16_t* dst = seg == 0 ? QR : KR; const float sc = seg == 0 ? 1.0f : 0.125f;
#pragma unroll
            for (int ai = 0; ai < 2; ++ai)
#pragma unroll
                for (int m = 0; m < 4; ++m) { const int row = rbase + ai * HALF + m * 16; const int pos = smp ? PAST + ((row - MP) & 3) : (row & (SEQ - 1));
                    const f32x4* rp = (const f32x4*)(rope + ((size_t)pos * 32 + 8 * fq) * 2);
                    f32x4 o1[2], o2[2];
#pragma unroll
                    for (int n = 0; n < 2; ++n) { const f32x4 ca = rp[2 * n], cb = rp[2 * n + 1]; const f32x4 x1 = acc[ai][0][m][n], x2 = acc[ai][1][m][n];
                        o1[n][0] = (x1[0] * ca[0] - x2[0] * ca[1]) * sc; o2[n][0] = (x1[0] * ca[1] + x2[0] * ca[0]) * sc;
                        o1[n][1] = (x1[1] * ca[2] - x2[1] * ca[3]) * sc; o2[n][1] = (x1[1] * ca[3] + x2[1] * ca[2]) * sc;
                        o1[n][2] = (x1[2] * cb[0] - x2[2] * cb[1]) * sc; o2[n][2] = (x1[2] * cb[1] + x2[2] * cb[0]) * sc;
                        o1[n][3] = (x1[3] * cb[2] - x2[3] * cb[3]) * sc; o2[n][3] = (x1[3] * cb[3] + x2[3] * cb[2]) * sc; }
                    bf16_t* d = dst + (size_t)row * WA + head * 64 + 8 * fq;
                    *(u32x4*)d = pack8(o1[0], o1[1]); *(u32x4*)(d + 32) = pack8(o2[0], o2[1]); }
        } else if (pn < 18) {
            const int seg = (pn - 14) >> 1, c0 = ((pn - 14) & 1) * 256 + cl; bf16_t* dst = seg == 0 ? VR : SZR;
#pragma unroll
            for (int ai = 0; ai < 2; ++ai)
#pragma unroll
                for (int m = 0; m < 4; ++m) { const int row = rbase + ai * HALF + m * 16;
#pragma unroll
                    for (int bj = 0; bj < 2; ++bj) { f32x4 v0 = acc[ai][bj][m][0], v1 = acc[ai][bj][m][1];
                        if (seg == 1) {
#pragma unroll
                            for (int e = 0; e < 4; ++e) { v0[e] = v0[e] * sigmoidf_(v0[e]); v1[e] = v1[e] * sigmoidf_(v1[e]); } }
                        *(u32x4*)(dst + (size_t)row * WA + c0 + bj * HALF) = pack8(v0, v1); } }
        } else {
            const int col = 128 * (pn - 18) + cl;
#pragma unroll
            for (int ai = 0; ai < 2; ++ai)
#pragma unroll
                for (int m = 0; m < 4; ++m) { const int row = rbase + ai * HALF + m * 16;
#pragma unroll
                    for (int bj = 0; bj < 2; ++bj) { f32x4 v0 = acc[ai][bj][m][0], v1 = acc[ai][bj][m][1];
#pragma unroll
                        for (int e = 0; e < 4; ++e) { v0[e] = sigmoidf_(v0[e]); v1[e] = sigmoidf_(v1[e]); }
                        *(u32x4*)((bj == 0 ? SGA : SGR) + (size_t)row * D + col) = pack8(v0, v1); } }
        }
    }
};
template <int MODE> struct EpiGate {
    static constexpr bool PERM = true, AFTER_DRAIN = false;
    const bf16_t* G; const bf16_t* T1in; bf16_t* O;
    __device__ __forceinline__ void operator()(const f32x4 (&acc)[2][2][4][2], const Unit& u, int wr, int wc, int fr, int fq) const {
        const int rbase = u.pm * BM + wr * 64 + fr, c0 = u.pn * BM + wc * 32 + 8 * fq;
#pragma unroll
        for (int ai = 0; ai < 2; ++ai)
#pragma unroll
            for (int m = 0; m < 4; ++m) { const size_t ro = (size_t)(rbase + ai * HALF + m * 16) * D;
#pragma unroll
                for (int bj = 0; bj < 2; ++bj) { const size_t off = ro + c0 + bj * HALF; const u32x4 g = *(const u32x4*)(G + off);
                    f32x4 v0 = acc[ai][bj][m][0], v1 = acc[ai][bj][m][1];
                    v0[0] *= bf_lo(g.x); v0[1] *= bf_hi(g.x); v0[2] *= bf_lo(g.y); v0[3] *= bf_hi(g.y); v1[0] *= bf_lo(g.z); v1[1] *= bf_hi(g.z); v1[2] *= bf_lo(g.w); v1[3] *= bf_hi(g.w);
                    if (MODE == 1) { const u32x4 t = *(const u32x4*)(T1in + off);
                        v0[0] += bf_lo(t.x); v0[1] += bf_hi(t.x); v0[2] += bf_lo(t.y); v0[3] += bf_hi(t.y); v1[0] += bf_lo(t.z); v1[1] += bf_hi(t.z); v1[2] += bf_lo(t.w); v1[3] += bf_hi(t.w); }
                    *(u32x4*)(O + off) = pack8(v0, v1); } }
    }
};
struct EpiOut {
    static constexpr bool PERM = false, AFTER_DRAIN = false;
    const float* xp; const float* xs; const float* mod; const float* bada; float* y;
    __device__ __forceinline__ void operator()(const f32x4 (&acc)[2][2][4][2], const Unit& u, int wr, int wc, int fr, int fq) const {
        const int rbase = u.pm * BM + wr * 64 + fr, c0 = u.pn * BM + wc * 32 + 4 * fq;
#pragma unroll
        for (int ai = 0; ai < 2; ++ai)
#pragma unroll
            for (int m = 0; m < 4; ++m) { const int row = rbase + ai * HALF + m * 16; if (row >= MR) continue;
                const float* xr = row < MP ? xp + (size_t)row * D : xs + (size_t)(row - MP) * D; const int mr = row < MP ? row / SEQ : 2 + ((row - MP) >> 2);
                const float* gr = mod + (size_t)mr * 3 * D + 2 * D; const float* br = bada + 2 * D; float* yr = y + (size_t)row * D;
#pragma unroll
                for (int bj = 0; bj < 2; ++bj)
#pragma unroll
                    for (int n = 0; n < 2; ++n) { const int col = c0 + bj * HALF + n * 16; const f32x4 g = *(const f32x4*)(gr + col) + *(const f32x4*)(br + col);
                        *(f32x4*)(yr + col) = *(const f32x4*)(xr + col) + g * acc[ai][bj][m][n]; } }
    }
};
template <class Epi, class Sched, bool ALIGN_EPI = false, bool SP2 = false>
__device__ __forceinline__ void gemm_phase(PG8_LAS unsigned char* lds, const Gemm g, const Sched& S, const Epi& E) {
    const int tid = threadIdx.x, wid = __builtin_amdgcn_readfirstlane(tid >> 6), lane = tid & 63, wr = wid >> 2, wc = wid & 3, fr = lane & 15, fq = lane >> 4;
    const int K = g.K, nt = K / BK;
    unsigned voffA[2], voffB[2];
#pragma unroll
    for (int i = 0; i < 2; ++i) { int R, C; stage_rc(tid * 16 + i * 8192, R, C); const int Rb = Epi::PERM ? ((R & ~31) + perm32(R & 31)) : R;
        voffA[i] = (unsigned)(R * K + C) * 2u; voffB[i] = (unsigned)(Rb * K + C) * 2u; }
    const size_t kstep = (size_t)(BK * 2);
    const size_t hstep = (size_t)HALF * K * 2;
    const size_t tstep = 2 * hstep;
    const unsigned ldsw = (unsigned)wid * 1024u;
    const int aoff = lds_byte(wr * 64 + fr, fq * 8), boff = lds_byte(wc * 32 + fr, fq * 8);
#define PG8_SA(b, h) (((b) * 2 + (h)) * HTB)
#define PG8_SB(b, h) ((4 + (b) * 2 + (h)) * HTB)
#define PG8_STAGE(bufoff, gbase, voff) do { _Pragma("unroll") for (int _i = 0; _i < 2; ++_i) \
        __builtin_amdgcn_global_load_lds((const unsigned*)((const char*)(gbase) + (voff)[_i]), (PG8_LAS unsigned*)(lds + (bufoff) + ldsw + _i * 8192), 16, 0, 0); } while (0)
#define PG8_LDA(dst, b, h) do { _Pragma("unroll") for (int m = 0; m < 4; ++m) _Pragma("unroll") for (int k = 0; k < 2; ++k) dst[m][k] = *(const PG8_LAS bf16x8*)(lds + PG8_SA(b, h) + aoff + m * 2048 + k * 1024); } while (0)
#define PG8_LDB(dst, b, h) do { _Pragma("unroll") for (int n = 0; n < 2; ++n) _Pragma("unroll") for (int k = 0; k < 2; ++k) dst[n][k] = *(const PG8_LAS bf16x8*)(lds + PG8_SB(b, h) + boff + n * 2048 + k * 1024); } while (0)
#define PG8_MMA(ai, bj, At, Bt) do { __builtin_amdgcn_s_setprio(1); _Pragma("unroll") for (int m = 0; m < 4; ++m) _Pragma("unroll") for (int n = 0; n < 2; ++n) _Pragma("unroll") for (int k = 0; k < 2; ++k) \
        acc[ai][bj][m][n] = __builtin_amdgcn_mfma_f32_16x16x32_bf16(Bt[n][k], At[m][k], acc[ai][bj][m][n], 0, 0, 0); __builtin_amdgcn_s_setprio(0); } while (0)
#define PG8_WAIT_V(n) asm volatile("s_waitcnt vmcnt(" #n ")" ::: "memory")
#define PG8_WAIT_L(n) asm volatile("s_waitcnt lgkmcnt(" #n ")" ::: "memory")
#define PG8_BAR __builtin_amdgcn_s_barrier()
#define PG8_SCHED __builtin_amdgcn_sched_barrier(0)
    Unit cur, nxt; int ui = 0;
    if (!S.next(0, cur)) return;
    f32x4 acc[2][2][4][2];
#pragma unroll
    for (int a = 0; a < 2; ++a)
#pragma unroll
        for (int b = 0; b < 2; ++b)
#pragma unroll
            for (int m = 0; m < 4; ++m)
#pragma unroll
                for (int n = 0; n < 2; ++n) acc[a][b][m][n] = (f32x4){0.f, 0.f, 0.f, 0.f};
    bf16x8 At[4][2], B0[2][2], B1[2][2];
    const char* cA = (const char*)g.A + (size_t)cur.pm * tstep; const char* cB = (const char*)g.Bt + (size_t)cur.pn * tstep;
    S.a_ready(cur);
    if constexpr (SP2) {
        PG8_STAGE(PG8_SB(0, 0), cB, voffB); PG8_STAGE(PG8_SB(0, 1), cB + hstep, voffB); PG8_STAGE(PG8_SA(0, 0), cA, voffA); PG8_STAGE(PG8_SA(0, 1), cA + hstep, voffA);
        if (wr == 1) PG8_BAR;
        PG8_WAIT_V(2); PG8_BAR;
        PG8_STAGE(PG8_SB(1, 0), cB + kstep, voffB); PG8_STAGE(PG8_SA(1, 0), cA + kstep, voffA); PG8_STAGE(PG8_SB(1, 1), cB + hstep + kstep, voffB);
        PG8_WAIT_V(6); PG8_BAR;
    } else {
        PG8_STAGE(PG8_SB(0, 0), cB, voffB); PG8_STAGE(PG8_SA(0, 0), cA, voffA); PG8_STAGE(PG8_SB(0, 1), cB + hstep, voffB); PG8_STAGE(PG8_SA(0, 1), cA + hstep, voffA);
        if (wr == 1) PG8_BAR;
        PG8_WAIT_V(4); PG8_BAR;
        PG8_STAGE(PG8_SB(1, 0), cB + kstep, voffB); PG8_STAGE(PG8_SA(1, 0), cA + kstep, voffA); PG8_STAGE(PG8_SB(1, 1), cB + hstep + kstep, voffB);
        PG8_WAIT_V(6); PG8_BAR;
    }
    for (;;) {
        const bool has_next = S.next(ui + 1, nxt);
        const char* nA = has_next ? (const char*)g.A + (size_t)nxt.pm * tstep : cA; const char* nB = has_next ? (const char*)g.Bt + (size_t)nxt.pn * tstep : cB;
        for (int t = 0; t < nt; t += 2) {
            const bool last = (t == nt - 2);
            const char* a1 = cA + (size_t)(t + 1) * kstep;
            const char* a2 = last ? nA : cA + (size_t)(t + 2) * kstep; const char* b2 = last ? nB : cB + (size_t)(t + 2) * kstep;
            const char* a3 = a2 + kstep; const char* b3 = b2 + kstep;
            if (last && has_next) S.a_ready(nxt);
            if constexpr (SP2) {
            PG8_LDB(B0, 0, 0); PG8_LDB(B1, 0, 1); PG8_SCHED; PG8_LDA(At, 0, 0); PG8_STAGE(PG8_SA(1, 1), a1 + hstep, voffA);
            PG8_WAIT_V(8); PG8_WAIT_L(0); PG8_BAR; PG8_MMA(0, 0, At, B0); PG8_MMA(0, 1, At, B1); PG8_BAR; PG8_SCHED;
            PG8_LDA(At, 0, 1); PG8_STAGE(PG8_SB(0, 0), b2, voffB); PG8_STAGE(PG8_SB(0, 1), b2 + hstep, voffB); PG8_STAGE(PG8_SA(0, 0), a2, voffA);
            PG8_WAIT_V(8); PG8_WAIT_L(0); PG8_BAR; PG8_MMA(1, 0, At, B0); PG8_MMA(1, 1, At, B1); PG8_BAR; PG8_SCHED;
            PG8_LDB(B0, 1, 0); PG8_LDB(B1, 1, 1); PG8_SCHED; PG8_LDA(At, 1, 0); PG8_STAGE(PG8_SA(0, 1), a2 + hstep, voffA);
            PG8_WAIT_V(8); PG8_WAIT_L(0); PG8_BAR; PG8_MMA(0, 0, At, B0); PG8_MMA(0, 1, At, B1); PG8_BAR; PG8_SCHED;
            PG8_LDA(At, 1, 1); PG8_STAGE(PG8_SB(1, 0), b3, voffB); PG8_STAGE(PG8_SB(1, 1), b3 + hstep, voffB); PG8_STAGE(PG8_SA(1, 0), a3, voffA);
            PG8_WAIT_V(8); PG8_WAIT_L(0); PG8_BAR; PG8_MMA(1, 0, At, B0); PG8_MMA(1, 1, At, B1); PG8_BAR; PG8_SCHED;
            } else {
            PG8_LDB(B0, 0, 0); PG8_SCHED; PG8_LDA(At, 0, 0); PG8_STAGE(PG8_SA(1, 1), a1 + hstep, voffA);
            PG8_WAIT_L(8); PG8_BAR; PG8_WAIT_L(0); PG8_MMA(0, 0, At, B0); PG8_BAR; PG8_SCHED;
            PG8_LDB(B1, 0, 1); PG8_STAGE(PG8_SB(0, 0), b2, voffB);
            PG8_BAR; PG8_WAIT_L(0); PG8_MMA(0, 1, At, B1); PG8_BAR;
            PG8_LDA(At, 0, 1); PG8_STAGE(PG8_SA(0, 0), a2, voffA);
            PG8_BAR; PG8_WAIT_L(0); PG8_MMA(1, 0, At, B0); PG8_BAR; PG8_SCHED;
            PG8_STAGE(PG8_SB(0, 1), b2 + hstep, voffB);
            PG8_WAIT_V(6); PG8_BAR; PG8_MMA(1, 1, At, B1); PG8_BAR;
            PG8_LDB(B0, 1, 0); PG8_SCHED; PG8_LDA(At, 1, 0); PG8_STAGE(PG8_SA(0, 1), a2 + hstep, voffA);
            PG8_WAIT_L(8); PG8_BAR; PG8_WAIT_L(0); PG8_MMA(0, 0, At, B0); PG8_BAR; PG8_SCHED;
            PG8_LDB(B1, 1, 1); PG8_STAGE(PG8_SB(1, 0), b3, voffB);
            PG8_BAR; PG8_WAIT_L(0); PG8_MMA(0, 1, At, B1); PG8_BAR;
            PG8_LDA(At, 1, 1); PG8_STAGE(PG8_SA(1, 0), a3, voffA);
            PG8_BAR; PG8_WAIT_L(0); PG8_MMA(1, 0, At, B0); PG8_BAR; PG8_SCHED;
            PG8_STAGE(PG8_SB(1, 1), b3 + hstep, voffB);
            PG8_WAIT_V(6); PG8_BAR; PG8_MMA(1, 1, At, B1); PG8_BAR;
            }
        }
        if constexpr (ALIGN_EPI) { if (wr == 0) PG8_BAR; }
        if constexpr (!Epi::AFTER_DRAIN) { E(acc, cur, wr, wc, fr, fq); S.done(cur); }
        if (!has_next) break;
#pragma unroll
        for (int a = 0; a < 2; ++a)
#pragma unroll
            for (int b = 0; b < 2; ++b)
#pragma unroll
                for (int m = 0; m < 4; ++m)
#pragma unroll
                    for (int n = 0; n < 2; ++n) acc[a][b][m][n] = (f32x4){0.f, 0.f, 0.f, 0.f};
        cur = nxt; cA = nA; cB = nB; ++ui;
        if constexpr (ALIGN_EPI) { if (wr == 1) PG8_BAR; }
    }
    PG8_WAIT_V(0);
    if constexpr (!ALIGN_EPI) { if (wr == 0) PG8_BAR; }
    PG8_BAR;
    if constexpr (Epi::AFTER_DRAIN) { E.fused(acc, cur, wr, wc, fr, fq, lds, wid, lane); S.done(cur); }
#undef PG8_SA
#undef PG8_SB
#undef PG8_STAGE
#undef PG8_LDA
#undef PG8_LDB
#undef PG8_MMA
#undef PG8_WAIT_V
#undef PG8_WAIT_L
#undef PG8_BAR
#undef PG8_SCHED
}
}
#include <hip/hip_bf16.h>
#include <cmath>
namespace attn_body {
using bf16=__hip_bfloat16;
using bf16x8=__attribute__((ext_vector_type(8)))short;
using s16x4=__attribute__((ext_vector_type(4)))short;
using f32x16=__attribute__((ext_vector_type(16)))float;
using u32x4=__attribute__((ext_vector_type(4)))unsigned;
constexpr int BATCH=2,NHEAD=8,SEQ=8192,D=64,DM=NHEAD*D;
constexpr int NW=8,QBLK=32,QB=QBLK*NW,KVBLK=64,NQB=SEQ/QB;
constexpr int ATTN_PITCH=DM, ATTN_UNIT_ROWS=QB;
__device__ __forceinline__ int crow(int r,int hi){return (r&3)+8*(r>>2)+4*hi;}
#define SBAR() __builtin_amdgcn_sched_barrier(0)
__device__ __forceinline__ void cmask(f32x16&p0,f32x16&p1,int jb,int qrel,int hi){
  const float NEG=-INFINITY; int kb=64*jb+4*hi;
  #pragma unroll
  for(int r=0;r<16;++r){int kv=kb+(r&3)+8*(r>>2); if(kv>qrel)p0[r]=NEG; if(kv+32>qrel)p1[r]=NEG;}
}

constexpr int NSLOT=3, SLOTB=8192;
constexpr int LDS_K=0, LDS_V=NSLOT*SLOTB, LDS_WS=2*NSLOT*SLOTB, LDS_OST=LDS_WS+NW*64*4, LDS_M=LDS_OST+NW*4096, LDS_BYTES=LDS_M+NW*768;
constexpr float C2=0.125f*1.4426950408889634f;
__device__ __forceinline__ void glds16(const void*gsrc,unsigned lds_dst){unsigned keep;
  asm volatile("s_mov_b32 %0, m0\n\ts_mov_b32 m0, %2\n\ts_nop 0\n\tglobal_load_lds_dwordx4 %1, off\n\ts_mov_b32 m0, %0":"=&s"(keep):"v"(gsrc),"s"(lds_dst):"memory");}
__device__ __forceinline__ void glds4(const void*gsrc,unsigned lds_dst){unsigned keep;
  asm volatile("s_mov_b32 %0, m0\n\ts_mov_b32 m0, %2\n\ts_nop 0\n\tglobal_load_lds_dword %1, off\n\ts_mov_b32 m0, %0":"=&s"(keep):"v"(gsrc),"s"(lds_dst):"memory");}
__device__ __forceinline__ void kmask(f32x16&p0,f32x16&p1,unsigned long long mw,int hi,float nm){
  const unsigned lo=(unsigned)mw>>(4*hi), hw=(unsigned)(mw>>32)>>(4*hi);
  #pragma unroll
  for(int r=0;r<16;++r){ const int c=(r&3)+8*(r>>2);
    const unsigned m0=(unsigned)((int)(lo<<(31-c))>>31), m1=(unsigned)((int)(hw<<(31-c))>>31);
    p0[r]=__uint_as_float((__float_as_uint(p0[r]+nm)&m0)|(0xff800000u&~m0));
    p1[r]=__uint_as_float((__float_as_uint(p1[r]+nm)&m1)|(0xff800000u&~m1)); }
}
__device__ __forceinline__ float max3f(float a,float b,float c){float r;asm("v_max3_f32 %0, %1, %2, %3":"=v"(r):"v"(a),"v"(b),"v"(c));return r;}
__device__ __forceinline__ float max2f(float a,float b){float r;asm("v_max_f32_e32 %0, %1, %2":"=v"(r):"v"(a),"v"(b));return r;}
__device__ __forceinline__ float fadd_s(float a,float b){float r;asm("v_add_f32_e32 %0, %1, %2":"=v"(r):"v"(a),"v"(b));return r;}
__device__ __forceinline__ float fsub_s(float a,float b){float r;asm("v_sub_f32_e32 %0, %1, %2":"=v"(r):"v"(a),"v"(b));return r;}
typedef float f32x2_t __attribute__((ext_vector_type(2))); typedef __bf16 bf16x2_t __attribute__((ext_vector_type(2)));
__device__ __forceinline__ unsigned cvtpk_s(float lo,float hi){f32x2_t v={lo,hi};bf16x2_t b=__builtin_convertvector(v,bf16x2_t);return __builtin_bit_cast(unsigned,b);}
#define WAIT_BAR(N) asm volatile("s_waitcnt vmcnt(" #N ") lgkmcnt(0)\n\ts_barrier":::"memory")

__device__ __forceinline__ void qkt(f32x16&p0,f32x16&p1,const char*Kslot,const bf16x8*qr,const f32x16&negm,int r32,int hi){
  const char*kb=Kslot+hi*1024+r32*16;
  #pragma unroll
  for(int d0=0;d0<4;++d0){
    const bf16x8 b0=*reinterpret_cast<const bf16x8*>(kb+d0*2048);
    const bf16x8 b1=*reinterpret_cast<const bf16x8*>(kb+d0*2048+512);
    if(d0==0){p0=__builtin_amdgcn_mfma_f32_32x32x16_bf16(b0,qr[0],negm,0,0,0);p1=__builtin_amdgcn_mfma_f32_32x32x16_bf16(b1,qr[0],negm,0,0,0);}
    else{p0=__builtin_amdgcn_mfma_f32_32x32x16_bf16(b0,qr[d0],p0,0,0,0);p1=__builtin_amdgcn_mfma_f32_32x32x16_bf16(b1,qr[d0],p1,0,0,0);}}
}
typedef __attribute__((address_space(3))) const char* lds_cptr;
typedef short v4i16_t __attribute__((ext_vector_type(4)));
__device__ __forceinline__ void kload8(bf16x8*kf,lds_cptr kp){
  kf[0]=*(const __attribute__((address_space(3))) bf16x8*)(kp);      kf[1]=*(const __attribute__((address_space(3))) bf16x8*)(kp+512);
  kf[2]=*(const __attribute__((address_space(3))) bf16x8*)(kp+2048); kf[3]=*(const __attribute__((address_space(3))) bf16x8*)(kp+2560);
  kf[4]=*(const __attribute__((address_space(3))) bf16x8*)(kp+4096); kf[5]=*(const __attribute__((address_space(3))) bf16x8*)(kp+4608);
  kf[6]=*(const __attribute__((address_space(3))) bf16x8*)(kp+6144); kf[7]=*(const __attribute__((address_space(3))) bf16x8*)(kp+6656);
}
__device__ __forceinline__ void kload2(bf16x8*kf,lds_cptr kp,int j){ kf[2*j]=*(const __attribute__((address_space(3))) bf16x8*)(kp+j*2048); kf[2*j+1]=*(const __attribute__((address_space(3))) bf16x8*)(kp+j*2048+512); }
__device__ __forceinline__ s16x4 vtr(lds_cptr p){ return __builtin_bit_cast(s16x4,__builtin_amdgcn_ds_read_tr16_b64_v4i16((__attribute__((address_space(3))) v4i16_t*)p)); }
__device__ __forceinline__ float rowmax(const f32x16&p0,const f32x16&p1){
  float a=max3f(p0[0],p0[1],p1[0]),b=max3f(p0[2],p0[3],p1[1]);a=max3f(a,p1[2],p1[3]);
  #pragma unroll
  for(int r=4;r<16;r+=4){a=max3f(a,p0[r],p0[r+1]);b=max3f(b,p0[r+2],p0[r+3]);a=max3f(a,p1[r],p1[r+1]);b=max3f(b,p1[r+2],p1[r+3]);}
  const float m=max2f(a,b);
  auto rr=__builtin_amdgcn_permlane32_swap(__float_as_uint(m),__float_as_uint(m),false,false);
  return max2f(__uint_as_float(rr[0]),__uint_as_float(rr[1]));
}
__device__ __forceinline__ void pv(f32x16*o,int vb,bf16x8 pa0,bf16x8 pa1,bf16x8 pa2,bf16x8 pa3){
  #pragma unroll
  for(int d0=0;d0<2;++d0){s16x4 lo[4],hi[4];
    #pragma unroll
    for(int ks=0;ks<4;++ks){
      asm volatile("ds_read_b64_tr_b16 %0,%1 offset:%c2":"=&v"(lo[ks]):"v"(vb),"i"(d0*4096+ks*1024):"memory");
      asm volatile("ds_read_b64_tr_b16 %0,%1 offset:%c2":"=&v"(hi[ks]):"v"(vb),"i"(d0*4096+ks*1024+512):"memory");}
    asm volatile("s_waitcnt lgkmcnt(0)":::"memory");SBAR();
    #define PK(k) (bf16x8){lo[k][0],lo[k][1],lo[k][2],lo[k][3],hi[k][0],hi[k][1],hi[k][2],hi[k][3]}
    o[d0]=__builtin_amdgcn_mfma_f32_32x32x16_bf16(pa0,PK(0),o[d0],0,0,0);
    o[d0]=__builtin_amdgcn_mfma_f32_32x32x16_bf16(pa1,PK(1),o[d0],0,0,0);
    o[d0]=__builtin_amdgcn_mfma_f32_32x32x16_bf16(pa2,PK(2),o[d0],0,0,0);
    o[d0]=__builtin_amdgcn_mfma_f32_32x32x16_bf16(pa3,PK(3),o[d0],0,0,0);
    #undef PK
  }
}

#ifndef ATTN_STORE16
#define ATTN_STORE16(p,v) (*(u32x4*)(p)=(v))
#endif
template<int THRL> __device__ __forceinline__ void attn_unit(int b,int h,int qb,const bf16*Q,const bf16*__restrict__ K,const bf16*__restrict__ V,bf16*O,const unsigned long long*__restrict__ MK,const bf16*__restrict__ SZ,char*shm){
  const int tid=threadIdx.x,lane=tid&63,r32=lane&31,hi=lane>>5; const int wid=__builtin_amdgcn_readfirstlane(tid>>6);
  const long rowbase=(long)b*SEQ; const int q0=qb*QB;
  const bf16*Qw=Q+(rowbase+q0+wid*QBLK)*DM+h*D;
  const bf16*Kh=K+rowbase*DM+h*D,*Vh=V+rowbase*DM+h*D;
  const unsigned lds0=(unsigned)(uintptr_t)shm;
  float*wsf=(float*)(shm+LDS_WS)+wid*64;
  const bf16*ksrc=Kh+(long)lane*DM+wid*8;
  const bf16*vsrc=Vh+(long)(16*(wid&3)+(lane>>2))*DM+(wid>>2)*32+(lane&3)*8;
  const unsigned kdst=lds0+LDS_K+wid*1024, vdst=lds0+LDS_V+wid*1024;
  #define DMA_K(t,slot) glds16(ksrc+(long)(t)*KVBLK*DM,(unsigned)__builtin_amdgcn_readfirstlane(kdst+(slot)))
  #define DMA_V(t,slot) glds16(vsrc+(long)(t)*KVBLK*DM,(unsigned)__builtin_amdgcn_readfirstlane(vdst+(slot)))
  const char*msrc=(const char*)(MK+((long)b*128*SEQ+q0+wid*QBLK))+lane*4; const unsigned mdst=lds0+LDS_M+wid*768;
  #define DMA_M(t,slot) glds4(msrc+(long)(t)*SEQ*8,(unsigned)__builtin_amdgcn_readfirstlane(mdst+((slot)>>5)))
  #define MWORD(slot) (*(const __attribute__((address_space(3))) unsigned long long*)(shm3+LDS_M+wid*768+((slot)>>5)+r32*8))
  const int vb0=(int)(lds0+LDS_V)+((lane>>4)&1)*32+(lane&3)*8+(4*hi+((lane&15)>>2))*64;
  const char*Kbase=shm+LDS_K; bf16x8 kf[8];
  const lds_cptr shm3=(lds_cptr)shm; const lds_cptr kp0=shm3+LDS_K+hi*1024+r32*16; const lds_cptr vp0=shm3+LDS_V+((lane>>4)&1)*32+(lane&3)*8+(4*hi+((lane&15)>>2))*64;
  const int NT=(q0+QB)/KVBLK;
  DMA_K(0,0);DMA_V(0,0);DMA_K(1,SLOTB);DMA_M(0,0);DMA_M(1,SLOTB);
  bf16x8 qr[4];
  #pragma unroll
  for(int d0=0;d0<4;++d0)qr[d0]=*reinterpret_cast<const bf16x8*>(&Qw[(long)r32*DM+d0*16+hi*8]);
  float mhat=0.f,l_reg=0.f;f32x16 o[2];o[0]=f32x16{};o[1]=f32x16{};const f32x16 negm=f32x16{};
  const int qrel=wid*QBLK+r32;
  bool resc=false;
  #define START(P0,P1) do{ const float rm=rowmax(P0,P1); resc=false; \
    { const float dl=(rm<-1e30f)?-16384.f:rm; mhat=fadd_s(mhat,dl); \
      _Pragma("unroll") for(int r=0;r<16;++r){P0[r]=fsub_s(P0[r],dl);P1[r]=fsub_s(P1[r],dl);} \
    } \
    _Pragma("unroll") for(int r=0;r<16;++r)P0[r]=__builtin_amdgcn_exp2f(P0[r]); }while(0)
  #define RESC() do{ if(resc){ asm volatile("s_waitcnt lgkmcnt(0)":::"memory"); \
      _Pragma("unroll") for(int d_=0;d_<2;++d_) _Pragma("unroll") for(int r=0;r<16;++r)o[d_][r]*=wsf[crow(r,hi)]; } }while(0)
  f32x16 pA0,pA1,pB0,pB1;
  int sl_prev=0,sl_cur=0,sl_next=SLOTB;
  #define ROT() do{sl_prev=sl_cur;sl_cur=sl_next;sl_next=(sl_next==(NSLOT-1)*SLOTB)?0:sl_next+SLOTB;}while(0)
  DMA_K(2,2*SLOTB);
  WAIT_BAR(1);
  qkt(pA0,pA1,Kbase,qr,negm,r32,hi);asm volatile("s_nop 15\n\ts_nop 7":"+v"(pA0),"+v"(pA1));kmask(pA0,pA1,MWORD(0),hi,0.f);
  START(pA0,pA1);
  _Pragma("unroll") for(int r=0;r<16;++r)pA1[r]=__builtin_amdgcn_exp2f(pA1[r]);
  WAIT_BAR(0);
  DMA_K(3,0);DMA_V(1,SLOTB);DMA_M(2,2*SLOTB);
  ROT();
  kload8(kf,kp0+sl_cur);
  WAIT_BAR(3);
  s16x4 vlo[8],vhi[8]; u32x4 pw0,pw1,pw2,pw3;
  #define PKW(P,B) cvtpk_s(P[B],P[B+1])
  #define PAF(k) __builtin_bit_cast(bf16x8,pw##k)
  #define VFR(i) (bf16x8){vlo[i][0],vlo[i][1],vlo[i][2],vlo[i][3],vhi[i][0],vhi[i][1],vhi[i][2],vhi[i][3]}
  #define PIN(x) asm volatile("":"+v"(x))
  #define MX3(a,b,c) __builtin_fmaxf(__builtin_fmaxf((a),(b)),(c))
  #define GAPA(MF,A0,A1,A2,A3,W0,W1,PW) do{ MF; sacc+=A0; sacc+=A1; sacc+=A2; sacc+=A3; PIN(sacc); W0; W1; PIN(PW); SBAR(); }while(0)
  #define EX(v) __builtin_amdgcn_exp2f(v)
  #define GAPB(MF,X,B) do{ MF; X[B]=EX(X[B]); X[B+1]=EX(X[B+1]); X[B+2]=EX(X[B+2]); X[B+3]=EX(X[B+3]); PIN(X); SBAR(); }while(0)
  #define VRD(i) do{ vlo[i]=vtr(vp_+(((i)>>2)*4096+((i)&3)*1024)); vhi[i]=vtr(vp_+(((i)>>2)*4096+((i)&3)*1024+512)); }while(0)
  #define KRD(G,j) do{ if(G){ kload2(kf,kp0+sl_next,j); SBAR(); } }while(0)
  #define STEP(C0,C1,P0,P1,t,GK,GV,GL,GM) do{ SBAR(); \
    const lds_cptr vp_=vp0+sl_prev; \
    VRD(0); SBAR(); float sacc=(P0[0]+P0[1]); \
    GAPA(C0=__builtin_amdgcn_mfma_f32_32x32x16_bf16(kf[0],qr[0],negm,0,0,0), P0[2],P0[3],P0[4],P0[5],     pw0[0]=PKW(P0,0), pw0[1]=PKW(P0,2), pw0); \
    VRD(4); SBAR(); GAPA(C1=__builtin_amdgcn_mfma_f32_32x32x16_bf16(kf[1],qr[0],negm,0,0,0), P0[6],P0[7],P0[8],P0[9],     pw0[2]=PKW(P0,4), pw0[3]=PKW(P0,6), pw0); \
    VRD(1); SBAR(); GAPA(C0=__builtin_amdgcn_mfma_f32_32x32x16_bf16(kf[2],qr[1],C0,0,0,0),   P0[10],P0[11],P0[12],P0[13], pw1[0]=PKW(P0,8), pw1[1]=PKW(P0,10), pw1); \
    VRD(5); SBAR(); GAPA(C1=__builtin_amdgcn_mfma_f32_32x32x16_bf16(kf[3],qr[1],C1,0,0,0),   P0[14],P0[15],P1[0],P1[1],   pw1[2]=PKW(P0,12),pw1[3]=PKW(P0,14), pw1); \
    VRD(2); SBAR(); GAPA(C0=__builtin_amdgcn_mfma_f32_32x32x16_bf16(kf[4],qr[2],C0,0,0,0),   P1[2],P1[3],P1[4],P1[5],     pw2[0]=PKW(P1,0), pw2[1]=PKW(P1,2), pw2); \
    VRD(6); SBAR(); GAPA(C1=__builtin_amdgcn_mfma_f32_32x32x16_bf16(kf[5],qr[2],C1,0,0,0),   P1[6],P1[7],P1[8],P1[9],     pw2[2]=PKW(P1,4), pw2[3]=PKW(P1,6), pw2); \
    VRD(3); SBAR(); GAPA(C0=__builtin_amdgcn_mfma_f32_32x32x16_bf16(kf[6],qr[3],C0,0,0,0),   P1[10],P1[11],P1[12],P1[13], pw3[0]=PKW(P1,8), pw3[1]=PKW(P1,10), pw3); \
    VRD(7); SBAR(); GAPA(C1=__builtin_amdgcn_mfma_f32_32x32x16_bf16(kf[7],qr[3],C1,0,0,0),   P1[14],P1[15],0.f,0.f,       pw3[2]=PKW(P1,12),pw3[3]=PKW(P1,14), pw3); \
    l_reg+=sacc; \
    if(GK){DMA_K((t)+3,sl_cur);} if(GV){DMA_V((t)+1,sl_next);} if(GM){DMA_M((t)+2,sl_prev);} \
    kmask(C0,C1,MWORD(sl_cur),hi,-mhat); \
    { float a=MX3(C0[0],C0[1],C1[0]),b=MX3(C0[2],C0[3],C1[1]); a=MX3(a,C1[2],C1[3]); \
      _Pragma("unroll") for(int r=4;r<16;r+=4){a=MX3(a,C0[r],C0[r+1]);b=MX3(b,C0[r+2],C0[r+3]);a=MX3(a,C1[r],C1[r+1]);b=MX3(b,C1[r+2],C1[r+3]);} \
      float rm=__builtin_fmaxf(a,b); { auto rr=__builtin_amdgcn_permlane32_swap(__float_as_uint(rm),__float_as_uint(rm),false,false); rm=__builtin_fmaxf(__uint_as_float(rr[0]),__uint_as_float(rr[1])); } \
      resc=false; \
      if(__builtin_expect(__any(rm>(float)THRL),0)){ const float dl=__builtin_fmaxf(rm,0.f); mhat+=dl; \
        _Pragma("unroll") for(int r=0;r<16;++r){C0[r]-=dl;C1[r]-=dl;} \
        const float f=__builtin_amdgcn_exp2f(-dl); l_reg*=f; if(hi==0)wsf[r32]=f; resc=true; } } \
    SBAR(); \
    GAPB(o[0]=__builtin_amdgcn_mfma_f32_32x32x16_bf16(PAF(0),VFR(0),o[0],0,0,0), C0,0); \
    GAPB(o[1]=__builtin_amdgcn_mfma_f32_32x32x16_bf16(PAF(0),VFR(4),o[1],0,0,0), C0,4); \
    KRD(GL,0); GAPB(o[0]=__builtin_amdgcn_mfma_f32_32x32x16_bf16(PAF(1),VFR(1),o[0],0,0,0), C0,8); \
    KRD(GL,1); GAPB(o[1]=__builtin_amdgcn_mfma_f32_32x32x16_bf16(PAF(1),VFR(5),o[1],0,0,0), C0,12); \
    KRD(GL,2); GAPB(o[0]=__builtin_amdgcn_mfma_f32_32x32x16_bf16(PAF(2),VFR(2),o[0],0,0,0), C1,0); \
    KRD(GL,3); GAPB(o[1]=__builtin_amdgcn_mfma_f32_32x32x16_bf16(PAF(2),VFR(6),o[1],0,0,0), C1,4); \
    GAPB(o[0]=__builtin_amdgcn_mfma_f32_32x32x16_bf16(PAF(3),VFR(3),o[0],0,0,0), C1,8); \
    GAPB(o[1]=__builtin_amdgcn_mfma_f32_32x32x16_bf16(PAF(3),VFR(7),o[1],0,0,0), C1,12); \
    }while(0)
  int t=1;
  for(;t+5<NT;t+=2){
    STEP(pB0,pB1,pA0,pA1,t,true,true,true,true);     WAIT_BAR(3); RESC(); ROT();
    STEP(pA0,pA1,pB0,pB1,t+1,true,true,true,true);   WAIT_BAR(3); RESC(); ROT();
  }
  #define ENDW(tt) do{ if((tt)+3<NT){WAIT_BAR(3);} else if((tt)+2<NT){WAIT_BAR(2);} else {WAIT_BAR(0);} }while(0)
  for(;t+1<NT;t+=2){
    STEP(pB0,pB1,pA0,pA1,t,(t+3<NT),(t+1<NT),(t+1<NT),(t+2<NT));       ENDW(t);   RESC(); ROT();
    STEP(pA0,pA1,pB0,pB1,t+1,(t+4<NT),(t+2<NT),(t+2<NT),(t+3<NT));     ENDW(t+1); RESC(); ROT();
  }
  STEP(pB0,pB1,pA0,pA1,NT-1,false,false,false,false); RESC();
  { float sacc=pB0[0]+pB0[1]; _Pragma("unroll") for(int r=2;r<16;++r)sacc+=pB0[r]; _Pragma("unroll") for(int r=0;r<16;++r)sacc+=pB1[r]; l_reg+=sacc;
    pw0=(u32x4){PKW(pB0,0),PKW(pB0,2),PKW(pB0,4),PKW(pB0,6)};pw1=(u32x4){PKW(pB0,8),PKW(pB0,10),PKW(pB0,12),PKW(pB0,14)};pw2=(u32x4){PKW(pB1,0),PKW(pB1,2),PKW(pB1,4),PKW(pB1,6)};pw3=(u32x4){PKW(pB1,8),PKW(pB1,10),PKW(pB1,12),PKW(pB1,14)};
    SBAR(); pv(o,vb0+sl_cur,PAF(0),PAF(1),PAF(2),PAF(3)); }
  #undef PKW
  #undef PAF
  #undef VFR
  #undef PIN
  #undef MX3
  #undef GAPA
  #undef GAPB
  #undef EX
  #undef VRD
  #undef KRD
  #undef STEP
  #undef ENDW
  {auto rr=__builtin_amdgcn_permlane32_swap(__float_as_uint(l_reg),__float_as_uint(l_reg),false,false);l_reg=__uint_as_float(rr[0])+__uint_as_float(rr[1]);}
  if(hi==0)wsf[32+r32]=l_reg;asm volatile("s_waitcnt lgkmcnt(0)":::"memory");
  float rli[16];
  #pragma unroll
  for(int r=0;r<16;++r)rli[r]=__builtin_amdgcn_rcpf(wsf[32+crow(r,hi)]);
  bf16*Ow=O+(rowbase+q0+wid*QBLK)*DM+h*D; const bf16*Zw=SZ+(rowbase+q0+wid*QBLK)*DM+h*D;
  { bf16*stg=(bf16*)(shm+LDS_OST)+wid*2048;
    #pragma unroll
    for(int r=0;r<16;++r){const int orow=crow(r,hi);
      #pragma unroll
      for(int d0=0;d0<2;++d0)stg[orow*64+d0*32+r32]=__float2bfloat16(o[d0][r]*rli[r]);}
    asm volatile("s_waitcnt lgkmcnt(0)":::"memory");
    #pragma unroll
    for(int i=0;i<4;++i){const int row=i*8+(lane>>3),ch=lane&7; const u32x4 v=*(const u32x4*)(stg+row*64+ch*8); const u32x4 z=*(const u32x4*)(Zw+(long)row*DM+ch*8); u32x4 y;
      y.x=cvtpk_s(__uint_as_float(v.x<<16)*__uint_as_float(z.x<<16),__uint_as_float(v.x&0xffff0000u)*__uint_as_float(z.x&0xffff0000u));
      y.y=cvtpk_s(__uint_as_float(v.y<<16)*__uint_as_float(z.y<<16),__uint_as_float(v.y&0xffff0000u)*__uint_as_float(z.y&0xffff0000u));
      y.z=cvtpk_s(__uint_as_float(v.z<<16)*__uint_as_float(z.z<<16),__uint_as_float(v.z&0xffff0000u)*__uint_as_float(z.z&0xffff0000u));
      y.w=cvtpk_s(__uint_as_float(v.w<<16)*__uint_as_float(z.w<<16),__uint_as_float(v.w&0xffff0000u)*__uint_as_float(z.w&0xffff0000u));
      ATTN_STORE16(Ow+(long)row*DM+ch*8,y);} }
  asm volatile("s_waitcnt lgkmcnt(0)\n\ts_barrier":::"memory");
  #undef DMA_K
  #undef DMA_V
  #undef DMA_M
  #undef MWORD
  #undef START
  #undef RESC
  #undef ROT
}
constexpr int ATTN_LDS_BYTES=LDS_BYTES;
struct AttnTensors { const bf16* Q; const bf16* K; const bf16* V; bf16* O; const unsigned long long* MK; const bf16* SZ; };
struct AttnUnit { int bh; int qb; };
struct StaticOrder {
  int vcu;
  __device__ __forceinline__ explicit StaticOrder(int grid,int block):vcu((block%8)*(grid/8)+block/8){}
  __device__ __forceinline__ bool next(int i,AttnUnit&u)const{ if(i>=2)return false; const int s=vcu&15; u.bh=vcu>>4; u.qb=(i==0)?s:31-s; return true; }
  __device__ __forceinline__ void a_ready(const AttnUnit&)const{}
  __device__ __forceinline__ void done(const AttnUnit&)const{}
};
template<class Sched,int THRL=8> __device__ __forceinline__ void attn_phase(char*lds,const AttnTensors&T,const Sched&S){
  AttnUnit u;
  for(int i=0;S.next(i,u);++i){ S.a_ready(u); attn_unit<THRL>(u.bh/NHEAD,u.bh%NHEAD,u.qb,T.Q,T.K,T.V,T.O,T.MK,T.SZ,lds); S.done(u); }
}
#undef SBAR
#undef WAIT_BAR
}
#define GAS __attribute__((address_space(1)))
#define LAS __attribute__((address_space(3)))
typedef unsigned short bf16;
typedef unsigned v4u __attribute__((ext_vector_type(4)));
typedef float f32x4 __attribute__((ext_vector_type(4)));
typedef short bf16x8 __attribute__((ext_vector_type(8)));
typedef GAS unsigned gu32;
typedef GAS unsigned long long gu64;
#define RLX_AGENT __ATOMIC_RELAXED, __HIP_MEMORY_SCOPE_AGENT
#define LDS_WAIT() asm volatile("s_waitcnt lgkmcnt(0)" ::: "memory")
#define VM_WAIT() asm volatile("s_waitcnt vmcnt(0)" ::: "memory")
__device__ __forceinline__ unsigned long long rt() { return __builtin_amdgcn_s_memrealtime(); }
__device__ __forceinline__ unsigned f2bf(float f) { unsigned u = __builtin_bit_cast(unsigned, f); return (u + 0x7fffu + ((u >> 16) & 1u)) >> 16; }
__device__ __forceinline__ unsigned pk2(float lo, float hi) { return f2bf(lo) | (f2bf(hi) << 16); }

#define XB_TMO      128
#define XB_XCNT(j)  (256  + 64 * (j))
#define XB_XSUB(j)  (1280 + 64 * (j))
#define XB_XGEN(j)  (2304 + 64 * (j))
#define XB_TOP      3328
#define XB_TOPGEN   3392
#define XCD_BAR_WORDS 3456
#define XB_SPIN_CAP (1u << 18)

__device__ __forceinline__ unsigned xb_ld(unsigned* p)              { return __hip_atomic_load(p, __ATOMIC_RELAXED, __HIP_MEMORY_SCOPE_AGENT); }
__device__ __forceinline__ unsigned xb_add(unsigned* p, unsigned v) { return __hip_atomic_fetch_add(p, v, __ATOMIC_RELAXED, __HIP_MEMORY_SCOPE_AGENT); }
__device__ __forceinline__ unsigned xb_xcc_id() { return (unsigned)__builtin_amdgcn_s_getreg((3 << 11) | 20) & 0xFu; }
#define XB_SPIN(cond, bar) do { unsigned _sp = 0; while (cond) { __builtin_amdgcn_s_sleep(1); \
    if ((++_sp & 255u) == 0u) { if (xb_ld(&(bar)[XB_TMO])) break; if (_sp > XB_SPIN_CAP) { atomicAdd(&(bar)[XB_TMO], 1u); break; } } } } while (0)

struct XcdBarrier {
    unsigned* bar; unsigned x;
    volatile LAS unsigned* st;
};

__device__ __forceinline__ XcdBarrier xcd_barrier_post(unsigned* bar, volatile LAS unsigned* st) {
    XcdBarrier b; b.bar = bar; b.x = xb_xcc_id(); b.st = st;
    if (threadIdx.x == 0) (void)xb_add(&bar[XB_XCNT(b.x)], 1u);
    return b;
}
__device__ __forceinline__ void xcd_barrier_complete(unsigned* bar, unsigned x, unsigned& nloc, unsigned& nx) {
    const unsigned G = gridDim.x * gridDim.y * gridDim.z;
    unsigned sum, cnt, mine, sp = 0u;
    for (;;) {
        sum = 0u; cnt = 0u; mine = 0u;
#pragma unroll
        for (unsigned j = 0; j < 16; ++j) { const unsigned c = xb_ld(&bar[XB_XCNT(j)]); sum += c; cnt += (c > 0u) ? 1u : 0u; mine = (j == x) ? c : mine; }
        if (sum == G) break;
        __builtin_amdgcn_s_sleep(1);
        if ((++sp & 255u) == 0u) { if (xb_ld(&bar[XB_TMO])) break; if (sp > XB_SPIN_CAP) { atomicAdd(&bar[XB_TMO], 1u); break; } }
    }
    nloc = mine > 0u ? mine : 1u; nx = cnt > 0u ? cnt : 1u;
}

__device__ __forceinline__ void xcd_barrier(const XcdBarrier& b) {
    asm volatile("s_waitcnt vmcnt(0)" ::: "memory");
    __syncthreads();
    if (threadIdx.x == 0) {
        unsigned* bar = b.bar;
        __builtin_amdgcn_s_waitcnt(0);
        unsigned nloc = b.st[0], nx = b.st[1];
        if (nloc == 0u) { xcd_barrier_complete(bar, b.x, nloc, nx); b.st[0] = nloc; b.st[1] = nx; }
        const unsigned old = xb_add(&bar[XB_XSUB(b.x)], 1u);
        const unsigned gen = old / nloc;
        if (old + 1u == (gen + 1u) * nloc) {
            __builtin_amdgcn_fence(__ATOMIC_RELEASE, "agent");
            asm volatile("s_waitcnt vmcnt(0)" ::: "memory");
            const unsigned og = xb_add(&bar[XB_TOP], 1u);
            const unsigned tg = og / nx;
            if (og + 1u == (tg + 1u) * nx) xb_add(&bar[XB_TOPGEN], 1u);
            else XB_SPIN(xb_ld(&bar[XB_TOPGEN]) == tg, bar);
            __builtin_amdgcn_fence(__ATOMIC_ACQUIRE, "agent");
            xb_add(&bar[XB_XGEN(b.x)], 1u);
            asm volatile("s_waitcnt vmcnt(0)" ::: "memory");
        } else {
            XB_SPIN(xb_ld(&bar[XB_XGEN(b.x)]) == gen, bar);
            __builtin_amdgcn_fence(__ATOMIC_ACQUIRE, "agent");
            asm volatile("s_waitcnt vmcnt(0)" ::: "memory");
        }
    }
    __syncthreads();
}
constexpr int NWAVES = 8;
#ifndef MK_N_LAUNCHES
#define MK_N_LAUNCHES 1
#endif
constexpr int N_PHASES = 9;
constexpr int N_LAUNCHES = MK_N_LAUNCHES;

constexpr size_t MiB = 1u << 20;
constexpr size_t WS_CTL = 0, CTL_ZERO_BYTES = 1 * MiB;
constexpr size_t WS_WIN = 2 * MiB;
constexpr size_t WS_WPA = 16 * MiB, WS_WPR = 17 * MiB, WS_WOUT = 18 * MiB;
constexpr size_t WS_ROPE = 20 * MiB;
constexpr size_t WS_H = 24 * MiB;
constexpr size_t WS_QA = 57 * MiB, WS_KA = 74 * MiB, WS_VA = 91 * MiB, WS_SZA = 108 * MiB;
constexpr size_t WS_QI = 125 * MiB, WS_KI = 134 * MiB, WS_WI = 137 * MiB;
constexpr size_t WS_QR = 138 * MiB, WS_KR = 155 * MiB, WS_VR = 172 * MiB, WS_SZR = 189 * MiB;
constexpr size_t WS_SGA = 206 * MiB, WS_SGR = 239 * MiB;
constexpr size_t WS_YA = 272 * MiB, WS_YR = 289 * MiB;
constexpr size_t WS_T1 = 306 * MiB, WS_MG = 339 * MiB;
constexpr size_t WS_MASK = 372 * MiB;
constexpr size_t WS_KVL = 388 * MiB;
constexpr size_t WS_SSC = 396 * MiB;
constexpr size_t WS_KIT = 402 * MiB;
constexpr size_t WS_END = 405 * MiB;
constexpr int SSC_LD = 8256;
static_assert(WS_WIN + (size_t)NINP * D * 2 <= WS_WPA && WS_ROPE + (size_t)8196 * 64 * 4 <= WS_H && WS_H + (size_t)MT * D * 2 <= WS_QA && WS_QA + (size_t)MT * WA * 2 <= WS_KA, "ws map");
static_assert(WS_QI + (size_t)MT * 256 * 2 <= WS_KI && WS_KI + (size_t)MT * 64 * 2 <= WS_WI && WS_WI + (size_t)MT * 16 <= WS_QR && WS_SGA + (size_t)MT * D * 2 <= WS_SGR && WS_SGR + (size_t)MT * D * 2 <= WS_YA, "ws map");
static_assert(WS_T1 + (size_t)MT * D * 2 <= WS_MG && WS_MG + (size_t)MT * D * 2 <= WS_MASK && WS_MASK + (size_t)2 * 128 * 8192 * 8 <= WS_KVL && WS_KVL + (size_t)2 * 8 * 32 * 4096 * 4 <= WS_SSC && WS_SSC + (size_t)MS * SSC_LD * 4 <= WS_END, "ws map");
constexpr int CW_TMO = 0, CW_CODE = 1;
constexpr int CW_BAR = 4096;
constexpr int CW_MOD = 16384;
static_assert((CW_MOD + NMOD * 3 * D) * 4 <= (int)CTL_ZERO_BYTES, "CTL words inside the memset region");

constexpr int RING_OFF = 0, RING_BYTES = 131072;
constexpr int LDSCTL_OFF = RING_BYTES, MISC_OFF = LDSCTL_OFF + 320;
constexpr int LDS_BYTES = 147456;
static_assert(MISC_OFF + 128 <= LDS_BYTES, "LDS map");
struct Frame {
    LAS unsigned char* lds;
    volatile LAS unsigned* MISC;
    gu32* ctl;
    int tid, lane, wave;
    int vcu, G;
    unsigned char* ws;
    const float *x_p, *x_s, *cache_k, *cache_v, *cache_ki, *state_ret; const int* page_table; const float *c_p, *c_s, *w_ada, *b_ada, *g_norm, *w_in, *g_ret, *w_pa, *w_pr, *w_out, *g_final;
    float* out;
};
__device__ __forceinline__ float wave_sum(float v) {
#pragma unroll
    for (int o = 1; o < 64; o <<= 1) v += __shfl_xor(v, o);
    return v;
}
__device__ __forceinline__ void p0_transpose_item(const float* W, int K, int N, bf16* WT, int nsrc, int cnt, int drow, int kb, LAS float* scr, int lane) {
    const int k0 = 64 * kb, nl = lane & 31;
#pragma unroll 8
    for (int i = 0; i < 32; ++i) { const int kk = 2 * i + (lane >> 5); scr[kk * 33 + nl] = (nsrc >= 0 && nl < cnt) ? W[(size_t)(k0 + kk) * N + nsrc + nl] : 0.f; }
    LDS_WAIT(); asm volatile("" ::: "memory");
    const int c = lane & 7;
#pragma unroll
    for (int j = 0; j < 4; ++j) { const int n = (lane >> 3) + 8 * j; const LAS float* s = scr + (8 * c) * 33 + n;
        v4u o; o.x = pk2(s[0 * 33], s[1 * 33]); o.y = pk2(s[2 * 33], s[3 * 33]); o.z = pk2(s[4 * 33], s[5 * 33]); o.w = pk2(s[6 * 33], s[7 * 33]);
        *(GAS v4u*)(WT + (size_t)(drow + n) * K + k0 + 8 * c) = o; }
    LDS_WAIT(); asm volatile("" ::: "memory");
}
__device__ __forceinline__ void win_group(int pg, int& nsrc, int& cnt) {
    const int pn = pg >> 3, gi = pg & 7, bj = gi >> 2, jg = gi & 3; cnt = 32;
    if (pn < 8) nsrc = pn * 256 + gi * 32;
    else if (pn == 8) nsrc = 2048 + gi * 32;
    else if (pn == 9) { if (gi < 2) nsrc = 2304 + gi * 32; else if (gi == 2) { nsrc = 2368; cnt = 4; } else nsrc = -1; }
    else if (pn < 14) { const int segbase = pn < 12 ? 2372 : 2884, head = 4 * ((pn - 10) & 1) + jg; nsrc = segbase + head * 64 + 32 * bj; }
    else if (pn < 18) nsrc = 3396 + (pn - 14) * 256 + gi * 32;
    else { const int g = pn - 18; nsrc = (bj == 0 ? 4420 : 5444) + 128 * g + 32 * jg; }
}
__device__ __forceinline__ float siluf_(float x) { return x * __builtin_amdgcn_rcpf(1.0f + __builtin_amdgcn_exp2f(-1.4426950408889634f * x)); }

__device__ __forceinline__ void p0_prologue(Frame& F) {
    LAS float* scr = (LAS float*)(F.lds + RING_OFF + F.wave * 16384);
    const int gw = F.vcu * NWAVES + F.wave, NGW = F.G * NWAVES;
    bf16* WIN = (bf16*)(F.ws + WS_WIN); bf16* WPA = (bf16*)(F.ws + WS_WPA); bf16* WPR = (bf16*)(F.ws + WS_WPR); bf16* WOUT = (bf16*)(F.ws + WS_WOUT);
    constexpr int I_IN = (NINP / 32) * (D / 64), I_PA = (D / 32) * (WA / 64), I_OUT = (D / 32) * (D / 64), I_MOD = 48 * 16;
    constexpr int NITEMS = I_MOD + I_IN + 2 * I_PA + I_OUT;
    for (int it = gw; it < NITEMS; it += NGW) {
        int r = it;
        if (r < I_MOD) {
            const int cg = r % 48, ks = r / 48, n = cg * 64 + F.lane, k0 = ks * 64;
            for (int i = F.lane; i < NMOD * 64; i += 64) { const int row = i >> 6, kk = i & 63; const float cv = row < 2 ? F.c_p[row * D + k0 + kk] : F.c_s[(row - 2) * D + k0 + kk]; scr[kk * 36 + row] = siluf_(cv); }
            LDS_WAIT(); asm volatile("" ::: "memory");
            float acc[NMOD];
#pragma unroll
            for (int j = 0; j < NMOD; ++j) acc[j] = 0.f;
#pragma unroll 4
            for (int kk = 0; kk < 64; ++kk) { const float w = F.w_ada[(size_t)(k0 + kk) * (3 * D) + n];
#pragma unroll
                for (int j = 0; j < NMOD; ++j) acc[j] += scr[kk * 36 + j] * w; }
            float* mod = (float*)(F.ctl + CW_MOD);
#pragma unroll
            for (int j = 0; j < NMOD; ++j) atomicAdd(mod + (size_t)j * 3 * D + n, acc[j]);
            LDS_WAIT(); asm volatile("" ::: "memory");
            continue;
        }
        r -= I_MOD;
        if (r < I_IN) { const int pg = r / (D / 64), kb = r % (D / 64); int nsrc, cnt; win_group(pg, nsrc, cnt); p0_transpose_item(F.w_in, D, NIN, WIN, nsrc, cnt, pg * 32, kb, scr, F.lane); continue; }
        r -= I_IN;
        if (r < I_PA) { const int pg = r / (WA / 64), kb = r % (WA / 64); p0_transpose_item(F.w_pa, WA, D, WPA, pg * 32, 32, pg * 32, kb, scr, F.lane); continue; }
        r -= I_PA;
        if (r < I_PA) { const int pg = r / (WA / 64), kb = r % (WA / 64); p0_transpose_item(F.w_pr, WA, D, WPR, pg * 32, 32, pg * 32, kb, scr, F.lane); continue; }
        r -= I_PA;
        { const int pg = r / (D / 64), kb = r % (D / 64); p0_transpose_item(F.w_out, D, D, WOUT, pg * 32, 32, pg * 32, kb, scr, F.lane); }
    }
    float* rope = (float*)(F.ws + WS_ROPE);
    for (int i = gw * 64 + F.lane; i < 8196 * 32; i += NGW * 64) { const int pos = i >> 5, d = i & 31;
        const float inv = __builtin_amdgcn_exp2f(-(float)d * 0.41524101186092029f); const float ang = (float)pos * inv;
        const float nrev = __builtin_rintf(ang * 0.15915494309189535f); float rr = __builtin_fmaf(-nrev, 6.2831854820251465f, ang); rr = __builtin_fmaf(-nrev, -1.7484555e-7f, rr);
        const float rev = rr * 0.15915494309189535f;
        *(float2*)(rope + (size_t)i * 2) = make_float2(__builtin_amdgcn_cosf(rev), __builtin_amdgcn_sinf(rev)); }
}
__device__ __forceinline__ void p1_hrows(Frame& F) {
    const int gw = F.vcu * NWAVES + F.wave, NGW = F.G * NWAVES;
    const float* mod = (const float*)(F.ctl + CW_MOD); bf16* H = (bf16*)(F.ws + WS_H);
    for (int m = gw; m < MT; m += NGW) {
        GAS unsigned long long* o8 = (GAS unsigned long long*)(H + (size_t)m * D) + F.lane;
        if (m >= MR) {
#pragma unroll
            for (int j = 0; j < 4; ++j) o8[64 * j] = 0ull;
            continue; }
        const float* xrow = m < MP ? F.x_p + (size_t)m * D : F.x_s + (size_t)(m - MP) * D; const int mr = m < MP ? m / SEQ : 2 + ((m - MP) >> 2);
        const GAS f32x4* xr = (const GAS f32x4*)xrow + F.lane;
        f32x4 v[4]; float s = 0.f;
#pragma unroll
        for (int j = 0; j < 4; ++j) { v[j] = xr[64 * j]; s += (v[j].x * v[j].x + v[j].y * v[j].y) + (v[j].z * v[j].z + v[j].w * v[j].w); }
        const float rstd = 1.0f / sqrtf(wave_sum(s) * (1.f / D) + EPS);
#pragma unroll
        for (int j = 0; j < 4; ++j) { const int col = 4 * F.lane + 256 * j;
            const f32x4 g = *(const f32x4*)(F.g_norm + col);
            const f32x4 sh = *(const f32x4*)(mod + (size_t)mr * 3 * D + col) + *(const f32x4*)(F.b_ada + col);
            const f32x4 sc = *(const f32x4*)(mod + (size_t)mr * 3 * D + D + col) + *(const f32x4*)(F.b_ada + D + col);
            const f32x4 hv = (v[j] * rstd) * g * (sc + 1.0f) + sh;
            o8[64 * j] = (unsigned long long)pk2(hv.x, hv.y) | ((unsigned long long)pk2(hv.z, hv.w) << 32); }
    }
}
__device__ __forceinline__ void p8_final(Frame& F) {
    const int gw = F.vcu * NWAVES + F.wave, NGW = F.G * NWAVES;
    for (int m = gw; m < MR; m += NGW) {
        GAS f32x4* yr = (GAS f32x4*)(F.out + (size_t)m * D) + F.lane;
        f32x4 v[4]; float s = 0.f;
#pragma unroll
        for (int j = 0; j < 4; ++j) { v[j] = yr[64 * j]; s += (v[j].x * v[j].x + v[j].y * v[j].y) + (v[j].z * v[j].z + v[j].w * v[j].w); }
        const float rstd = 1.0f / sqrtf(wave_sum(s) * (1.f / D) + EPS);
#pragma unroll
        for (int j = 0; j < 4; ++j) { const f32x4 g = *(const f32x4*)(F.g_final + 4 * F.lane + 256 * j); yr[64 * j] = (v[j] * rstd) * g; }
    }
}
typedef float f32x16 __attribute__((ext_vector_type(16)));
typedef short s16x4 __attribute__((ext_vector_type(4)));
__device__ __forceinline__ float l2gamma(int h) {
    const float x = __builtin_ldexpf(1.0f, -5 - h);
    const float p = x * (1.0f + x * (0.5f + x * (0.33333334f + x * (0.25f + x * (0.2f + x * 0.16666667f)))));
    return -p * 1.4426950408889634f;
}
__device__ __forceinline__ int crow16(int r, int hi) { return (r & 3) + 8 * (r >> 2) + 4 * hi; }
constexpr int RC = 256, NCH = SEQ / RC;
constexpr int R_TS = 264;
constexpr int R_KS = 72;
__device__ __forceinline__ void ret_local_unit(Frame& F, int b, int h, int c) {
    const bf16* KR = (const bf16*)(F.ws + WS_KR); const bf16* VR = (const bf16*)(F.ws + WS_VR); float* KVL = (float*)(F.ws + WS_KVL);
    LAS bf16* AT = (LAS bf16*)(F.lds + RING_OFF); LAS bf16* BT = AT + 64 * R_TS; LAS float* RED = (LAS float*)(F.lds + RING_OFF + 2 * 64 * R_TS * 2);
    const int tid = F.tid, lane = F.lane, w = F.wave; const float lg = l2gamma(h);
    const size_t R0 = (size_t)b * SEQ + (size_t)c * RC;
    {   const int j = tid >> 1, half = tid & 1; const float sc = __builtin_amdgcn_exp2f((float)(RC - 1 - j) * lg);
        const v4u* kp = (const v4u*)(KR + (R0 + j) * WA + h * 64 + 32 * half); const v4u* vp = (const v4u*)(VR + (R0 + j) * WA + h * 64 + 32 * half);
#pragma unroll
        for (int i = 0; i < 4; ++i) { const v4u kw = kp[i], vw = vp[i]; const unsigned ka[4] = {kw.x, kw.y, kw.z, kw.w}, va[4] = {vw.x, vw.y, vw.z, vw.w};
#pragma unroll
            for (int e = 0; e < 4; ++e) { const int d = 32 * half + 8 * i + 2 * e;
                AT[d * R_TS + j] = (bf16)f2bf(pg8::bf_lo(ka[e]) * sc); AT[(d + 1) * R_TS + j] = (bf16)f2bf(pg8::bf_hi(ka[e]) * sc);
                BT[d * R_TS + j] = (bf16)(va[e] & 0xffffu); BT[(d + 1) * R_TS + j] = (bf16)(va[e] >> 16); } }
    }
    __syncthreads();
    const int tile = w & 3, mt = tile >> 1, nt = tile & 1, kh = w >> 2, l32 = lane & 31, hi = lane >> 5;
    f32x16 acc = {};
#pragma unroll
    for (int ks = 0; ks < 8; ++ks) { const int k0 = 16 * (8 * kh + ks) + 8 * hi;
        const bf16x8 a = *(const LAS bf16x8*)(AT + (32 * mt + l32) * R_TS + k0); const bf16x8 bq = *(const LAS bf16x8*)(BT + (32 * nt + l32) * R_TS + k0);
        acc = __builtin_amdgcn_mfma_f32_32x32x16_bf16(a, bq, acc, 0, 0, 0); }
    if (kh == 1) {
#pragma unroll
        for (int r = 0; r < 16; ++r) RED[tile * 1024 + r * 64 + lane] = acc[r]; }
    __syncthreads();
    if (kh == 0) { float* o = KVL + (((size_t)(b * NH + h) * NCH + c) << 12);
#pragma unroll
        for (int r = 0; r < 16; ++r) o[(32 * mt + crow16(r, hi)) * 64 + 32 * nt + l32] = acc[r] + RED[tile * 1024 + r * 64 + lane]; }
    __syncthreads();
}
__device__ __forceinline__ void ret_out_unit(Frame& F, int b, int h, int c) {
    const bf16* QR = (const bf16*)(F.ws + WS_QR); const bf16* KR = (const bf16*)(F.ws + WS_KR); const bf16* VR = (const bf16*)(F.ws + WS_VR); const bf16* SZR = (const bf16*)(F.ws + WS_SZR);
    bf16* YR = (bf16*)(F.ws + WS_YR); const float* KVL = (const float*)(F.ws + WS_KVL) + (((size_t)(b * NH + h) * NCH) << 12);
    LAS bf16* Ks = (LAS bf16*)(F.lds + RING_OFF); LAS bf16* VT = Ks + RC * R_KS; LAS bf16* SpT = VT + 64 * R_TS;
    const int tid = F.tid, lane = F.lane, w = F.wave, l32 = lane & 31, hi = lane >> 5; const float lg = l2gamma(h);
    const size_t R0 = (size_t)b * SEQ + (size_t)c * RC;
    {
        const float gC = __builtin_amdgcn_exp2f((float)RC * lg), g1 = __builtin_amdgcn_exp2f(lg);
        f32x4 s0 = {0.f, 0.f, 0.f, 0.f}, s1 = {0.f, 0.f, 0.f, 0.f}; const float* kp = KVL + tid * 8;
        for (int m = 0; m < c; ++m) { const f32x4 a0 = *(const f32x4*)(kp + ((size_t)m << 12)), a1 = *(const f32x4*)(kp + ((size_t)m << 12) + 4); s0 = s0 * gC + a0; s1 = s1 * gC + a1; }
        const int dk = tid >> 3, dv0 = (tid & 7) * 8;
#pragma unroll
        for (int e = 0; e < 4; ++e) { SpT[(dv0 + e) * R_KS + dk] = (bf16)f2bf(s0[e] * g1); SpT[(dv0 + 4 + e) * R_KS + dk] = (bf16)f2bf(s1[e] * g1); }
        if (c == NCH - 1) { const f32x4 a0 = *(const f32x4*)(kp + ((size_t)c << 12)), a1 = *(const f32x4*)(kp + ((size_t)c << 12) + 4);
            float* o = F.out + O_RSP + ((size_t)(b * NH + h) << 12) + tid * 8; *(f32x4*)o = s0 * gC + a0; *(f32x4*)(o + 4) = s1 * gC + a1; }
    }
    {   const int j = tid >> 1, half = tid & 1; const float sc = __builtin_amdgcn_exp2f(-(float)j * lg);
        const v4u* kp = (const v4u*)(KR + (R0 + j) * WA + h * 64 + 32 * half); const v4u* vp = (const v4u*)(VR + (R0 + j) * WA + h * 64 + 32 * half);
#pragma unroll
        for (int i = 0; i < 4; ++i) { const v4u kw = kp[i], vw = vp[i]; const unsigned va[4] = {vw.x, vw.y, vw.z, vw.w};
            v4u ko; ko.x = pk2(pg8::bf_lo(kw.x) * sc, pg8::bf_hi(kw.x) * sc); ko.y = pk2(pg8::bf_lo(kw.y) * sc, pg8::bf_hi(kw.y) * sc); ko.z = pk2(pg8::bf_lo(kw.z) * sc, pg8::bf_hi(kw.z) * sc); ko.w = pk2(pg8::bf_lo(kw.w) * sc, pg8::bf_hi(kw.w) * sc);
            *(LAS v4u*)(Ks + j * R_KS + 32 * half + 8 * i) = ko;
#pragma unroll
            for (int e = 0; e < 4; ++e) { const int d = 32 * half + 8 * i + 2 * e; VT[d * R_TS + j] = (bf16)(va[e] & 0xffffu); VT[(d + 1) * R_TS + j] = (bf16)(va[e] >> 16); } }
    }
    bf16x8 qf[4];
    {   const int i = 32 * w + l32; const float sc = __builtin_amdgcn_exp2f((float)i * lg); const bf16* qp = QR + (R0 + i) * WA + h * 64 + 8 * hi;
#pragma unroll
        for (int ks = 0; ks < 4; ++ks) { const v4u qw = *(const v4u*)(qp + 16 * ks); v4u o;
            o.x = pk2(pg8::bf_lo(qw.x) * sc, pg8::bf_hi(qw.x) * sc); o.y = pk2(pg8::bf_lo(qw.y) * sc, pg8::bf_hi(qw.y) * sc); o.z = pk2(pg8::bf_lo(qw.z) * sc, pg8::bf_hi(qw.z) * sc); o.w = pk2(pg8::bf_lo(qw.w) * sc, pg8::bf_hi(qw.w) * sc);
            qf[ks] = __builtin_bit_cast(bf16x8, o); }
    }
    __syncthreads();
    f32x16 o0 = {}, o1 = {};
    for (int jb = 0; jb <= w; ++jb) {
        f32x16 s = {};
#pragma unroll
        for (int ks = 0; ks < 4; ++ks) { const bf16x8 a = *(const LAS bf16x8*)(Ks + (32 * jb + l32) * R_KS + 16 * ks + 8 * hi); s = __builtin_amdgcn_mfma_f32_32x32x16_bf16(a, qf[ks], s, 0, 0, 0); }
        if (jb == w) {
#pragma unroll
            for (int r = 0; r < 16; ++r) if (crow16(r, hi) > l32) s[r] = 0.f; }
#pragma unroll
        for (int sx = 0; sx < 2; ++sx) { v4u pw; pw.x = pk2(s[8 * sx + 0], s[8 * sx + 1]); pw.y = pk2(s[8 * sx + 2], s[8 * sx + 3]); pw.z = pk2(s[8 * sx + 4], s[8 * sx + 5]); pw.w = pk2(s[8 * sx + 6], s[8 * sx + 7]);
            const bf16x8 pf = __builtin_bit_cast(bf16x8, pw); const int jo = 32 * jb + 16 * sx + 4 * hi;
            { const s16x4 lo = *(const LAS s16x4*)(VT + l32 * R_TS + jo), hh = *(const LAS s16x4*)(VT + l32 * R_TS + jo + 8);
              const bf16x8 a = {lo[0], lo[1], lo[2], lo[3], hh[0], hh[1], hh[2], hh[3]}; o0 = __builtin_amdgcn_mfma_f32_32x32x16_bf16(a, pf, o0, 0, 0, 0); }
            { const s16x4 lo = *(const LAS s16x4*)(VT + (32 + l32) * R_TS + jo), hh = *(const LAS s16x4*)(VT + (32 + l32) * R_TS + jo + 8);
              const bf16x8 a = {lo[0], lo[1], lo[2], lo[3], hh[0], hh[1], hh[2], hh[3]}; o1 = __builtin_amdgcn_mfma_f32_32x32x16_bf16(a, pf, o1, 0, 0, 0); } }
    }
#pragma unroll
    for (int ks = 0; ks < 4; ++ks) { const bf16x8 a0 = *(const LAS bf16x8*)(SpT + l32 * R_KS + 16 * ks + 8 * hi), a1 = *(const LAS bf16x8*)(SpT + (32 + l32) * R_KS + 16 * ks + 8 * hi);
        o0 = __builtin_amdgcn_mfma_f32_32x32x16_bf16(a0, qf[ks], o0, 0, 0, 0); o1 = __builtin_amdgcn_mfma_f32_32x32x16_bf16(a1, qf[ks], o1, 0, 0, 0); }
    float sm = 0.f;
#pragma unroll
    for (int r = 0; r < 16; ++r) sm += o0[r] + o1[r];
    sm += __shfl_xor(sm, 32); const float mean = sm * (1.f / 64.f); float sq = 0.f;
#pragma unroll
    for (int r = 0; r < 16; ++r) { const float d0 = o0[r] - mean, d1 = o1[r] - mean; sq += d0 * d0 + d1 * d1; }
    sq += __shfl_xor(sq, 32); const float rstd = 1.0f / sqrtf(sq * (1.f / 64.f) + EPS);
    const size_t row = R0 + 32 * w + l32;
#pragma unroll
    for (int blk = 0; blk < 2; ++blk)
#pragma unroll
        for (int g = 0; g < 4; ++g) { const int dv = 32 * blk + 8 * g + 4 * hi; const size_t off = row * WA + h * 64 + dv;
            const uint2 z = *(const uint2*)(SZR + off); const f32x4 gr = *(const f32x4*)(F.g_ret + h * 64 + dv);
            const float v0 = ((blk ? o1[4 * g + 0] : o0[4 * g + 0]) - mean) * rstd * gr[0] * pg8::bf_lo(z.x), v1 = ((blk ? o1[4 * g + 1] : o0[4 * g + 1]) - mean) * rstd * gr[1] * pg8::bf_hi(z.x);
            const float v2 = ((blk ? o1[4 * g + 2] : o0[4 * g + 2]) - mean) * rstd * gr[2] * pg8::bf_lo(z.y), v3 = ((blk ? o1[4 * g + 3] : o0[4 * g + 3]) - mean) * rstd * gr[3] * pg8::bf_hi(z.y);
            uint2 ow; ow.x = pk2(v0, v1); ow.y = pk2(v2, v3); *(uint2*)(YR + off) = ow; }
    __syncthreads();
}
__device__ __forceinline__ void ret_sample_unit(Frame& F, int db, int h, LAS float* scr) {
    const bf16* QR = (const bf16*)(F.ws + WS_QR); const bf16* KR = (const bf16*)(F.ws + WS_KR); const bf16* VR = (const bf16*)(F.ws + WS_VR); const bf16* SZR = (const bf16*)(F.ws + WS_SZR);
    bf16* YR = (bf16*)(F.ws + WS_YR); const int lane = F.lane; const float lg = l2gamma(h);
    float q[4], k[4], v[4];
#pragma unroll
    for (int t = 0; t < 4; ++t) { const size_t off = (size_t)(MP + 4 * db + t) * WA + h * 64 + lane;
        q[t] = __uint_as_float((unsigned)QR[off] << 16); k[t] = __uint_as_float((unsigned)KR[off] << 16); v[t] = __uint_as_float((unsigned)VR[off] << 16);
        scr[t * 64 + lane] = q[t]; scr[256 + t * 64 + lane] = k[t]; }
    LDS_WAIT(); asm volatile("" ::: "memory");
    const float g1 = __builtin_amdgcn_exp2f(lg), g2 = g1 * g1, g3 = g2 * g1, g4 = g2 * g2;
    const float* S = F.state_ret + ((size_t)(db * NH + h) << 12); float* So = F.out + O_RSS + ((size_t)(db * NH + h) << 12);
    float qs[4] = {0.f, 0.f, 0.f, 0.f};
#pragma unroll 4
    for (int d = 0; d < 64; ++d) { const float s = S[d * 64 + lane];
        qs[0] += scr[d] * s; qs[1] += scr[64 + d] * s; qs[2] += scr[128 + d] * s; qs[3] += scr[192 + d] * s;
        So[d * 64 + lane] = g4 * s + (g3 * scr[256 + d] * v[0] + g2 * scr[320 + d] * v[1]) + (g1 * scr[384 + d] * v[2] + scr[448 + d] * v[3]); }
    const float gp[4] = {1.f, g1, g2, g3};
#pragma unroll
    for (int i = 0; i < 4; ++i) { float o = gp[i] * g1 * qs[i];
#pragma unroll
        for (int j = 0; j <= i; ++j) { const float dot = wave_sum(q[i] * k[j]); o += gp[i - j] * dot * v[j]; }
        const float mean = wave_sum(o) * (1.f / 64.f); const float dd = o - mean; const float rstd = 1.0f / sqrtf(wave_sum(dd * dd) * (1.f / 64.f) + EPS);
        const size_t off = (size_t)(MP + 4 * db + i) * WA + h * 64 + lane;
        YR[off] = (bf16)f2bf(dd * rstd * F.g_ret[h * 64 + lane] * __uint_as_float((unsigned)SZR[off] << 16)); }
    LDS_WAIT(); asm volatile("" ::: "memory");
}
constexpr int IX_CAP = 1536, IX_TRIG = 1024, IX_NE = IX_CAP / 64;
constexpr int IX_BUF = 0, IX_BITS = 16 * IX_CAP * 4, IX_HIST = IX_BITS + 16384, IX_CNT = IX_HIST + 8192, IX_TAU = IX_CNT + 64;
static_assert(IX_TAU + 64 <= 131072, "indexer LDS");
typedef __fp16 h2f_t __attribute__((ext_vector_type(2))); typedef _Float16 h2_t __attribute__((ext_vector_type(2)));
#define IX_DPP(old, x, ctrl, rmask) ((unsigned)__builtin_amdgcn_update_dpp((int)(old), (int)(x), (ctrl), (rmask), 0xf, false))
__device__ __forceinline__ unsigned wave_scan_add(unsigned x) {
    x += IX_DPP(0u, x, 0x111, 0xf); x += IX_DPP(0u, x, 0x112, 0xf); x += IX_DPP(0u, x, 0x114, 0xf); x += IX_DPP(0u, x, 0x118, 0xf);
    x += IX_DPP(0u, x, 0x142, 0xa); x += IX_DPP(0u, x, 0x143, 0xc); return x; }
__device__ __forceinline__ unsigned wave_min_u(unsigned x) { unsigned t;
    t = IX_DPP(x, x, 0x111, 0xf); x = t < x ? t : x; t = IX_DPP(x, x, 0x112, 0xf); x = t < x ? t : x; t = IX_DPP(x, x, 0x114, 0xf); x = t < x ? t : x; t = IX_DPP(x, x, 0x118, 0xf); x = t < x ? t : x;
    t = IX_DPP(x, x, 0x142, 0xa); x = t < x ? t : x; t = IX_DPP(x, x, 0x143, 0xc); x = t < x ? t : x; return (unsigned)__builtin_amdgcn_readlane((int)x, 63); }
__device__ __forceinline__ unsigned wave_max_u(unsigned x) { unsigned t;
    t = IX_DPP(x, x, 0x111, 0xf); x = t > x ? t : x; t = IX_DPP(x, x, 0x112, 0xf); x = t > x ? t : x; t = IX_DPP(x, x, 0x114, 0xf); x = t > x ? t : x; t = IX_DPP(x, x, 0x118, 0xf); x = t > x ? t : x;
    t = IX_DPP(x, x, 0x142, 0xa); x = t > x ? t : x; t = IX_DPP(x, x, 0x143, 0xc); x = t > x ? t : x; return (unsigned)__builtin_amdgcn_readlane((int)x, 63); }
__device__ __forceinline__ unsigned ix_order(unsigned raw) { unsigned k = raw & ~8191u; k = (k & 0x7fffffffu) ? k : 0u;
    const unsigned ok = (k ^ ((unsigned)((int)k >> 31) | 0x80000000u)) & ~8191u; return ok | (raw & 8191u); }
__device__ __forceinline__ float ix_decode(unsigned e) { const unsigned k = e & ~8191u; const unsigned b = (k & 0x80000000u) ? (k & 0x7fffffffu) : ~k; return __uint_as_float(b & ~8191u); }
__device__ __forceinline__ void ix_cross(LAS unsigned* hist, int need, int lane, unsigned& d, unsigned& above, unsigned& cd) {
    const int base = 252 - 4 * lane; const v4u h4 = *(const LAS v4u*)(hist + base);
    const unsigned sl = h4.x + h4.y + h4.z + h4.w; const unsigned incl = wave_scan_add(sl), excl = incl - sl;
    const bool here = excl < (unsigned)need && (unsigned)need <= incl;
    unsigned c = excl, dd, ab, cc;
    if (c + h4.w >= (unsigned)need) { dd = base + 3; ab = c; cc = h4.w; }
    else { c += h4.w; if (c + h4.z >= (unsigned)need) { dd = base + 2; ab = c; cc = h4.z; }
        else { c += h4.z; if (c + h4.y >= (unsigned)need) { dd = base + 1; ab = c; cc = h4.y; } else { c += h4.y; dd = base; ab = c; cc = h4.x; } } }
    const unsigned long long bm = __ballot(here); const int L = bm ? (int)__builtin_ctzll(bm) : 0;
    d = (unsigned)__builtin_amdgcn_readlane((int)dd, L); above = (unsigned)__builtin_amdgcn_readlane((int)ab, L); cd = (unsigned)__builtin_amdgcn_readlane((int)cc, L);
}
template <int NE, bool EXACT> __device__ __forceinline__ unsigned ix_select2(LAS unsigned* hist, const unsigned (&e)[NE], int n, int need, int lane) {
    unsigned emn = ~0u, emx = 0u;
#pragma unroll
    for (int i = 0; i < NE; ++i) if (lane + 64 * i < n) { emn = e[i] < emn ? e[i] : emn; emx = e[i] > emx ? e[i] : emx; }
    const float fmn = ix_decode(wave_min_u(emn)), fmx = ix_decode(wave_max_u(emx));
    const float scale = (fmx > fmn) ? 255.5f / (fmx - fmn) : 0.f;
    *(LAS v4u*)(hist + 4 * lane) = (v4u){0u, 0u, 0u, 0u};
#pragma unroll
    for (int i = 0; i < NE; ++i) { int bi = (int)((ix_decode(e[i]) - fmn) * scale); bi = bi < 0 ? 0 : (bi > 255 ? 255 : bi);
        if (lane + 64 * i < n) (void)__hip_atomic_fetch_add(hist + bi, 1u, __ATOMIC_RELAXED, __HIP_MEMORY_SCOPE_WORKGROUP); }
    unsigned d, above, cd; ix_cross(hist, need, lane, d, above, cd);
    unsigned mn = ~0u, mx = 0u;
#pragma unroll
    for (int i = 0; i < NE; ++i) { unsigned ee = e[i]; asm volatile("" : "+v"(ee)); int bi = (int)((ix_decode(ee) - fmn) * scale); bi = bi < 0 ? 0 : (bi > 255 ? 255 : bi);
        if (lane + 64 * i < n && bi == (int)d) { mn = e[i] < mn ? e[i] : mn; mx = e[i] > mx ? e[i] : mx; } }
    unsigned lo = wave_min_u(mn), hi = wave_max_u(mx);
    need -= (int)above;
    if (!EXACT || (int)cd == need) return lo;
    for (int iter = 0; iter < 8; ++iter) {
        const unsigned range = hi - lo;
        if (range == 0u) return lo;
        int sh = 24 - (int)__builtin_clz(range); sh = sh < 0 ? 0 : sh;
        *(LAS v4u*)(hist + 4 * lane) = (v4u){0u, 0u, 0u, 0u};
#pragma unroll
        for (int i = 0; i < NE; ++i) if (lane + 64 * i < n && e[i] >= lo && e[i] <= hi) (void)__hip_atomic_fetch_add(hist + ((e[i] - lo) >> sh), 1u, __ATOMIC_RELAXED, __HIP_MEMORY_SCOPE_WORKGROUP);
        ix_cross(hist, need, lane, d, above, cd);
        need -= (int)above;
        const unsigned lo2 = lo + (d << sh); unsigned top = lo2 + ((1u << sh) - 1u); if (top < lo2) top = ~0u;
        if ((int)cd == need) return lo2;
        lo = lo2; hi = top < hi ? top : hi;
    }
    return lo;
}
#define IX_BAR() asm volatile("s_waitcnt lgkmcnt(0)\n\ts_barrier" ::: "memory")
__device__ __forceinline__ void index_unit(Frame& F, int b, int qb) {
    const bf16* QI = (const bf16*)(F.ws + WS_QI); const bf16* KIT = (const bf16*)(F.ws + WS_KIT); const float* WI = (const float*)(F.ws + WS_WI);
    unsigned long long* MASK = (unsigned long long*)(F.ws + WS_MASK);
    LAS unsigned* BUF = (LAS unsigned*)(F.lds + RING_OFF + IX_BUF); LAS unsigned* BITS = (LAS unsigned*)(F.lds + RING_OFF + IX_BITS);
    LAS unsigned* HIST = (LAS unsigned*)(F.lds + RING_OFF + IX_HIST) + F.wave * 256; LAS unsigned* CNT = (LAS unsigned*)(F.lds + RING_OFF + IX_CNT); LAS float* TAUF = (LAS float*)(F.lds + RING_OFF + IX_TAU);
    const int tid = F.tid, lane = F.lane, w = F.wave, l32 = lane & 31, hi = lane >> 5;
    const int p0 = 16 * qb; const size_t R0 = (size_t)b * SEQ + p0;
    const int nt = ((p0 + 15) >> 5) + 1, rounds = (nt + 15) >> 4;
    if (tid < 16) { CNT[tid] = 0u; TAUF[tid] = -INFINITY; }
    for (int i = tid; i < 16 * 256; i += 512) BITS[i] = 0u;
    bf16x8 af[2][4]; h2_t w01[8], w23[8];
#pragma unroll
    for (int rb = 0; rb < 2; ++rb) {
#pragma unroll
        for (int ks = 0; ks < 4; ++ks) af[rb][ks] = *(const bf16x8*)(QI + (R0 + rb * 8 + (l32 >> 2)) * 256 + (l32 & 3) * 64 + 16 * ks + 8 * hi);
#pragma unroll
        for (int g = 0; g < 4; ++g) { const f32x4 wq = *(const f32x4*)(WI + (R0 + rb * 8 + 2 * g + hi) * 4);
            w01[rb * 4 + g] = __builtin_bit_cast(h2_t, __builtin_amdgcn_cvt_pkrtz(wq[0], wq[1])); w23[rb * 4 + g] = __builtin_bit_cast(h2_t, __builtin_amdgcn_cvt_pkrtz(wq[2], wq[3])); } }
    const bf16* kbase = KIT + (((size_t)b * (SEQ / 32) * 8 + hi) * 32 + l32) * 8;
    bf16x8 kb0[4], kb1[4];
    if (2 * w < nt) {
#pragma unroll
        for (int ks = 0; ks < 4; ++ks) kb0[ks] = *(const bf16x8*)(kbase + (size_t)(2 * w) * 2048 + 512 * ks); }
    if (2 * w + 1 < nt) {
#pragma unroll
        for (int ks = 0; ks < 4; ++ks) kb1[ks] = *(const bf16x8*)(kbase + (size_t)(2 * w + 1) * 2048 + 512 * ks); }
    IX_BAR(); TS_ADD(27);
    for (int rd = 0; rd < rounds; ++rd) {
        float tau[8];
#pragma unroll
        for (int s8 = 0; s8 < 8; ++s8) tau[s8] = TAUF[(s8 >> 2) * 8 + 2 * (s8 & 3) + hi];
        f32x16 a00 = {}, a01 = {}, a10 = {}, a11 = {};
        const int tile0 = 16 * rd + 2 * w, tile1 = tile0 + 1;
        if (tile0 < nt) {
#pragma unroll
            for (int ks = 0; ks < 4; ++ks) { a00 = __builtin_amdgcn_mfma_f32_32x32x16_bf16(af[0][ks], kb0[ks], a00, 0, 0, 0); a01 = __builtin_amdgcn_mfma_f32_32x32x16_bf16(af[1][ks], kb0[ks], a01, 0, 0, 0); } }
        if (tile1 < nt) {
#pragma unroll
            for (int ks = 0; ks < 4; ++ks) { a10 = __builtin_amdgcn_mfma_f32_32x32x16_bf16(af[0][ks], kb1[ks], a10, 0, 0, 0); a11 = __builtin_amdgcn_mfma_f32_32x32x16_bf16(af[1][ks], kb1[ks], a11, 0, 0, 0); } }
        if (tile0 + 16 < nt) {
#pragma unroll
            for (int ks = 0; ks < 4; ++ks) kb0[ks] = *(const bf16x8*)(kbase + (size_t)(tile0 + 16) * 2048 + 512 * ks); }
        if (tile1 + 16 < nt) {
#pragma unroll
            for (int ks = 0; ks < 4; ++ks) kb1[ks] = *(const bf16x8*)(kbase + (size_t)(tile1 + 16) * 2048 + 512 * ks); }
#pragma unroll
        for (int half = 0; half < 2; ++half) {
            const int tile = tile0 + half;
            if (tile < nt) {
                const int key = 32 * tile + l32; const bool diag = (32 * tile + 31 > p0); const unsigned kcode = (unsigned)(8191 - key);
                float sc[8]; bool ps[8]; unsigned slot[8];
#pragma unroll
                for (int s8 = 0; s8 < 8; ++s8) { const int rb = s8 >> 2, g = s8 & 3; const h2_t z2 = {0, 0};
                    const f32x16& ar = half ? (rb ? a11 : a10) : (rb ? a01 : a00);
                    const float x0 = ar[4 * g], x1 = ar[4 * g + 1], x2 = ar[4 * g + 2], x3 = ar[4 * g + 3];
                    const h2_t r01 = __builtin_elementwise_max(__builtin_bit_cast(h2_t, __builtin_amdgcn_cvt_pkrtz(x0, x1)), z2), r23 = __builtin_elementwise_max(__builtin_bit_cast(h2_t, __builtin_amdgcn_cvt_pkrtz(x2, x3)), z2);
                    sc[s8] = __builtin_amdgcn_fdot2(w23[s8], r23, __builtin_amdgcn_fdot2(w01[s8], r01, 0.0f, false), false);
                    ps[s8] = sc[s8] > tau[s8]; }
                if (diag) {
#pragma unroll
                    for (int s8 = 0; s8 < 8; ++s8) ps[s8] = ps[s8] && (key <= p0 + (s8 >> 2) * 8 + 2 * (s8 & 3) + hi); }
                if (rd < 3) {
#pragma unroll
                    for (int s8 = 0; s8 < 8; ++s8) if (ps[s8]) BUF[((s8 >> 2) * 8 + 2 * (s8 & 3) + hi) * IX_CAP + key] = (__float_as_uint(sc[s8]) & ~8191u) | kcode;
                } else {
#pragma unroll
                    for (int s8 = 0; s8 < 8; ++s8) { slot[s8] = 0u; if (ps[s8]) slot[s8] = __hip_atomic_fetch_add(CNT + (s8 >> 2) * 8 + 2 * (s8 & 3) + hi, 1u, __ATOMIC_RELAXED, __HIP_MEMORY_SCOPE_WORKGROUP); }
#pragma unroll
                    for (int s8 = 0; s8 < 8; ++s8) if (ps[s8] && slot[s8] < (unsigned)IX_CAP) BUF[((s8 >> 2) * 8 + 2 * (s8 & 3) + hi) * IX_CAP + slot[s8]] = (__float_as_uint(sc[s8]) & ~8191u) | kcode;
                }
            }
        }
        IX_BAR(); TS_ADD(24);
#pragma unroll 1
        for (int qq = 2 * w; qq < 2 * w + 2; ++qq) { int n = (int)CNT[qq];
            if (rd < 3) { const int seen = 512 * (rd + 1); n = p0 + qq + 1 < seen ? p0 + qq + 1 : seen; if (lane == 0) CNT[qq] = (unsigned)n; }
            n = n > IX_CAP ? IX_CAP : n;
            if (n > IX_TRIG) { unsigned e[IX_NE];
#pragma unroll
                for (int i = 0; i < IX_NE; ++i) e[i] = (lane + 64 * i < n) ? ix_order(BUF[qq * IX_CAP + lane + 64 * i]) : 0u;
                const unsigned T = ix_select2<IX_NE, false>(HIST, e, n, TOPK, lane);
                int base = 0;
#pragma unroll
                for (int i = 0; i < IX_NE; ++i) { const bool keep = (lane + 64 * i < n) && e[i] >= T; const unsigned long long m = __ballot(keep);
                    if (keep) { const unsigned k19 = e[i] & ~8191u; const unsigned braw = (k19 & 0x80000000u) ? (k19 & 0x7fffffffu) : (~k19 & ~8191u);
                        BUF[qq * IX_CAP + base + __builtin_amdgcn_mbcnt_hi((unsigned)(m >> 32), __builtin_amdgcn_mbcnt_lo((unsigned)m, 0u))] = braw | (e[i] & 8191u); }
                    base += __builtin_popcountll(m); }
                if (lane == 0) { CNT[qq] = (unsigned)base; TAUF[qq] = ix_decode(T); } } }
        IX_BAR(); TS_ADD(25);
    }
#pragma unroll 1
    for (int qq = 2 * w; qq < 2 * w + 2; ++qq) { int n = (int)CNT[qq]; n = n > IX_CAP ? IX_CAP : n; unsigned e[IX_NE];
#pragma unroll
        for (int i = 0; i < IX_NE; ++i) e[i] = (lane + 64 * i < n) ? ix_order(BUF[qq * IX_CAP + lane + 64 * i]) : 0u;
        unsigned T = 0u; if (n > TOPK) T = ix_select2<IX_NE, true>(HIST, e, n, TOPK, lane);
#pragma unroll
        for (int i = 0; i < IX_NE; ++i) if ((lane + 64 * i < n) && e[i] >= T) { const unsigned idx = 8191u - (e[i] & 8191u); (void)__hip_atomic_fetch_or(BITS + qq * 256 + (idx >> 5), 1u << (idx & 31), __ATOMIC_RELAXED, __HIP_MEMORY_SCOPE_WORKGROUP); } }
    IX_BAR();
    {   const int ntm = 4 * ((p0 >> 8) + 1), q = tid & 15;
        for (int t = tid >> 4; t < ntm; t += 32) { const unsigned lo = BITS[q * 256 + 2 * t], hh = BITS[q * 256 + 2 * t + 1];
            MASK[((size_t)(b * 128 + t) << 13) + p0 + q] = (unsigned long long)lo | ((unsigned long long)hh << 32); } }
    IX_BAR(); TS_ADD(26);
}
typedef float f32x4v __attribute__((ext_vector_type(4)));
__device__ __forceinline__ void sscore_unit(Frame& F, int db, int ch) {
    const bf16* QI = (const bf16*)(F.ws + WS_QI); const bf16* KI = (const bf16*)(F.ws + WS_KI); const float* WI = (const float*)(F.ws + WS_WI); float* SSC = (float*)(F.ws + WS_SSC);
    const int lane = F.lane, w = F.wave, c16 = lane & 15, kq = lane >> 4;
    bf16x8 af[2];
#pragma unroll
    for (int ks = 0; ks < 2; ++ks) af[ks] = *(const bf16x8*)(QI + (size_t)(MP + 4 * db + (c16 >> 2)) * 256 + (c16 & 3) * 64 + 32 * ks + 8 * kq);
    const f32x4 wq = *(const f32x4*)(WI + (size_t)(MP + 4 * db + kq) * 4);
    float* srow = SSC + (size_t)(4 * db + kq) * SSC_LD;
#pragma unroll 2
    for (int tl = 0; tl < 8; ++tl) { const int key = 1024 * ch + 128 * w + 16 * tl + c16;
        const int phys = F.page_table[db * NPAGES + (key >> 7)]; const float* kp = F.cache_ki + ((size_t)phys * PAGE + (key & 127)) * HDI + 8 * kq;
        f32x4 acc = {0.f, 0.f, 0.f, 0.f};
#pragma unroll
        for (int ks = 0; ks < 2; ++ks) { const f32x4 k0 = *(const f32x4*)(kp + 32 * ks), k1 = *(const f32x4*)(kp + 32 * ks + 4);
            v4u kw; kw.x = pk2(k0[0], k0[1]); kw.y = pk2(k0[2], k0[3]); kw.z = pk2(k1[0], k1[1]); kw.w = pk2(k1[2], k1[3]);
            acc = __builtin_amdgcn_mfma_f32_16x16x32_bf16(af[ks], __builtin_bit_cast(bf16x8, kw), acc, 0, 0, 0); }
        float s = wq[0] * fmaxf(acc[0], 0.f); s = __builtin_fmaf(wq[1], fmaxf(acc[1], 0.f), s); s = __builtin_fmaf(wq[2], fmaxf(acc[2], 0.f), s); s = __builtin_fmaf(wq[3], fmaxf(acc[3], 0.f), s);
        srow[key] = s; }
    if (ch == 7 && w == 0) {
        f32x4 acc = {0.f, 0.f, 0.f, 0.f};
#pragma unroll
        for (int ks = 0; ks < 2; ++ks) { bf16x8 bq = {0, 0, 0, 0, 0, 0, 0, 0}; if (c16 < 4) bq = *(const bf16x8*)(KI + (size_t)(MP + 4 * db + c16) * HDI + 32 * ks + 8 * kq);
            acc = __builtin_amdgcn_mfma_f32_16x16x32_bf16(af[ks], bq, acc, 0, 0, 0); }
        float s = wq[0] * fmaxf(acc[0], 0.f); s = __builtin_fmaf(wq[1], fmaxf(acc[1], 0.f), s); s = __builtin_fmaf(wq[2], fmaxf(acc[2], 0.f), s); s = __builtin_fmaf(wq[3], fmaxf(acc[3], 0.f), s);
        if (c16 < 4) srow[PAST + c16] = s; }
}
constexpr int SA_SC = 0, SA_SEL = 33792, SA_RB = 34816, SA_HIST = 35840, SA_LG = 36864  , SA_MISC = 45056;
__device__ __forceinline__ unsigned sa_select(LAS unsigned* hist, const LAS unsigned* keys, int n, int need, int lane) {
    unsigned mn = ~0u, mx = 0u;
    for (int i = lane; i < n; i += 64) { const unsigned e = keys[i]; mn = e < mn ? e : mn; mx = e > mx ? e : mx; }
    unsigned lo = wave_min_u(mn), hi = wave_max_u(mx);
    for (int iter = 0; iter < 8; ++iter) {
        const unsigned range = hi - lo;
        if (range == 0u) return lo;
        int sh = 24 - (int)__builtin_clz(range); sh = sh < 0 ? 0 : sh;
        *(LAS v4u*)(hist + 4 * lane) = (v4u){0u, 0u, 0u, 0u};
        LDS_WAIT(); asm volatile("" ::: "memory");
        for (int i = lane; i < n; i += 64) { const unsigned e = keys[i]; if (e >= lo && e <= hi) (void)__hip_atomic_fetch_add(hist + ((e - lo) >> sh), 1u, __ATOMIC_RELAXED, __HIP_MEMORY_SCOPE_WORKGROUP); }
        LDS_WAIT(); asm volatile("" ::: "memory");
        const v4u h4 = *(const LAS v4u*)(hist + 4 * lane);
        const unsigned sl = h4.x + h4.y + h4.z + h4.w; unsigned incl = sl;
#pragma unroll
        for (int o = 1; o < 64; o <<= 1) { const unsigned t = (unsigned)__shfl_down((int)incl, o); if (lane + o < 64) incl += t; }
        const unsigned excl = incl - sl; const bool here = excl < (unsigned)need && (unsigned)need <= incl;
        unsigned d = 0, above = 0, cd = 0;
        { unsigned c = excl; bool fnd = false;
          if (!fnd) { if (c + h4.w >= (unsigned)need) { d = 4 * lane + 3; above = c; cd = h4.w; fnd = true; } else c += h4.w; }
          if (!fnd) { if (c + h4.z >= (unsigned)need) { d = 4 * lane + 2; above = c; cd = h4.z; fnd = true; } else c += h4.z; }
          if (!fnd) { if (c + h4.y >= (unsigned)need) { d = 4 * lane + 1; above = c; cd = h4.y; fnd = true; } else c += h4.y; }
          if (!fnd) { d = 4 * lane; above = c; cd = h4.x; } }
        const unsigned long long bm = __ballot(here); const int L = bm ? (int)__builtin_ctzll(bm) : 0;
        d = (unsigned)__shfl((int)d, L); above = (unsigned)__shfl((int)above, L); cd = (unsigned)__shfl((int)cd, L);
        need -= (int)above;
        const unsigned lo2 = lo + (d << sh); unsigned top = lo2 + ((1u << sh) - 1u); if (top < lo2) top = ~0u;
        if ((int)cd == need) return lo2;
        lo = lo2; hi = top < hi ? top : hi;
    }
    return lo;
}
__device__ __forceinline__ unsigned okey_f(float s) { unsigned b = __float_as_uint(s); b = (b == 0x80000000u) ? 0u : b; return b ^ ((unsigned)((int)b >> 31) | 0x80000000u); }
__device__ __forceinline__ void sattn_unit(Frame& F, int sq) {
    const int db = sq >> 2, t = sq & 3, n = PAST + t + 1; const int tid = F.tid, lane = F.lane, h = F.wave;
    const float* SSC = (const float*)(F.ws + WS_SSC) + (size_t)sq * SSC_LD; const bf16* QA = (const bf16*)(F.ws + WS_QA); const bf16* SZA = (const bf16*)(F.ws + WS_SZA); bf16* YA = (bf16*)(F.ws + WS_YA);
    LAS unsigned* SC = (LAS unsigned*)(F.lds + RING_OFF + SA_SC); LAS unsigned* SEL = (LAS unsigned*)(F.lds + RING_OFF + SA_SEL); LAS unsigned* RB = (LAS unsigned*)(F.lds + RING_OFF + SA_RB);
    LAS unsigned* HIST = (LAS unsigned*)(F.lds + RING_OFF + SA_HIST); LAS float* LG = (LAS float*)(F.lds + RING_OFF + SA_LG) + h * 256;
    for (int i = tid; i < n; i += 512) SC[i] = okey_f(SSC[i]);
    __syncthreads();
    if (h == 0) {
        const unsigned T = sa_select(HIST, SC, n, TOPK, lane);
        int cgt = 0; for (int i = lane; i < n; i += 64) cgt += SC[i] > T ? 1 : 0;
        cgt = (int)wave_sum((float)cgt);
        int need_eq = TOPK - cgt, base = 0;
        for (int i0 = 0; i0 < n; i0 += 64) { const int i = i0 + lane; const unsigned e = i < n ? SC[i] : 0u; const bool gt = i < n && e > T; bool eq = i < n && e == T;
            const unsigned long long me = __ballot(eq); const int pe = __builtin_popcountll(me & ((1ull << lane) - 1ull)); eq = eq && pe < need_eq;
            const int taken = __builtin_popcountll(me); need_eq -= taken < need_eq ? taken : need_eq;
            const bool tk = gt || eq; const unsigned long long mt = __ballot(tk);
            if (tk) SEL[base + __builtin_popcountll(mt & ((1ull << lane) - 1ull))] = (unsigned)i; base += __builtin_popcountll(mt); }
    }
    __syncthreads();
    if (tid < TOPK) { const unsigned idx = SEL[tid]; RB[tid] = idx < (unsigned)PAST ? (unsigned)F.page_table[db * NPAGES + (idx >> 7)] * PAGE + (idx & 127u) : (0x80000000u | (idx - PAST)); }
    __syncthreads();
    const int jg = lane >> 4, dc = lane & 15; const size_t qrow = (size_t)(MP + sq) * WA + h * 64 + 4 * dc;
    float q4[4]; { const uint2 qw = *(const uint2*)(QA + qrow); q4[0] = pg8::bf_lo(qw.x); q4[1] = pg8::bf_hi(qw.x); q4[2] = pg8::bf_lo(qw.y); q4[3] = pg8::bf_hi(qw.y); }
    const float* knew = F.out + O_KS + (size_t)(db * 4) * WA + h * 64 + 4 * dc; const float* vnew = F.out + O_VS + (size_t)(db * 4) * WA + h * 64 + 4 * dc;
#pragma unroll 8
    for (int it = 0; it < 64; ++it) { const int j = 4 * it + jg; const unsigned rb = RB[j];
        const float* kp = (rb & 0x80000000u) ? knew + (size_t)(rb & 3u) * WA : F.cache_k + ((size_t)rb * NH + h) * 64 + 4 * dc;
        const f32x4 k4 = *(const f32x4*)kp; float d = (q4[0] * k4[0] + q4[1] * k4[1]) + (q4[2] * k4[2] + q4[3] * k4[3]);
        d += __shfl_xor(d, 1); d += __shfl_xor(d, 2); d += __shfl_xor(d, 4); d += __shfl_xor(d, 8);
        if (dc == 0) LG[j] = d; }
    LDS_WAIT(); asm volatile("" ::: "memory");
    float lv[4], mx = -INFINITY;
#pragma unroll
    for (int i = 0; i < 4; ++i) { lv[i] = LG[lane + 64 * i]; mx = fmaxf(mx, lv[i]); }
#pragma unroll
    for (int o = 1; o < 64; o <<= 1) mx = fmaxf(mx, __shfl_xor(mx, o));
    float sm = 0.f;
#pragma unroll
    for (int i = 0; i < 4; ++i) { lv[i] = __builtin_amdgcn_exp2f(lv[i] - mx); sm += lv[i]; }
    sm = wave_sum(sm);
#pragma unroll
    for (int i = 0; i < 4; ++i) LG[lane + 64 * i] = lv[i];
    LDS_WAIT(); asm volatile("" ::: "memory");
    f32x4 o4 = {0.f, 0.f, 0.f, 0.f};
#pragma unroll 8
    for (int it = 0; it < 64; ++it) { const int j = 4 * it + jg; const unsigned rb = RB[j]; const float p = LG[j];
        const float* vp = (rb & 0x80000000u) ? vnew + (size_t)(rb & 3u) * WA : F.cache_v + ((size_t)rb * NH + h) * 64 + 4 * dc;
        o4 += *(const f32x4*)vp * p; }
#pragma unroll
    for (int e = 0; e < 4; ++e) { o4[e] += __shfl_xor(o4[e], 16); o4[e] += __shfl_xor(o4[e], 32); }
    if (jg == 0) { const float rl = 1.0f / sm; const uint2 z = *(const uint2*)(SZA + qrow);
        uint2 y; y.x = pk2(o4[0] * rl * pg8::bf_lo(z.x), o4[1] * rl * pg8::bf_hi(z.x)); y.y = pk2(o4[2] * rl * pg8::bf_lo(z.y), o4[3] * rl * pg8::bf_hi(z.y));
        *(uint2*)(YA + qrow) = y; }
    __syncthreads();
}
__device__ __forceinline__ f32x16 mini_acc(const bf16* A, int lda, const bf16* Bt, int ldb, int k0, int nk16, int l32, int hi) {
    f32x16 acc = {};
    const bf16* ap = A + (size_t)l32 * lda + k0 + 8 * hi; const bf16* bp = Bt + (size_t)l32 * ldb + k0 + 8 * hi;
#pragma unroll 4
    for (int ks = 0; ks < nk16; ++ks) { const bf16x8 a = *(const bf16x8*)(ap + 16 * ks), bq = *(const bf16x8*)(bp + 16 * ks); acc = __builtin_amdgcn_mfma_f32_32x32x16_bf16(a, bq, acc, 0, 0, 0); }
    return acc;
}
__device__ __forceinline__ void mini_merge_unit(Frame& F, int c) {
    const bf16* YA = (const bf16*)(F.ws + WS_YA); const bf16* YR = (const bf16*)(F.ws + WS_YR); const bf16* WPA = (const bf16*)(F.ws + WS_WPA); const bf16* WPR = (const bf16*)(F.ws + WS_WPR);
    const bf16* SGA = (const bf16*)(F.ws + WS_SGA); const bf16* SGR = (const bf16*)(F.ws + WS_SGR); bf16* MG = (bf16*)(F.ws + WS_MG);
    LAS float* RED = (LAS float*)(F.lds + RING_OFF);
    const int lane = F.lane, w = F.wave, l32 = lane & 31, hi = lane >> 5, rb = w & 3, kh = w >> 2;
    const size_t r0 = (size_t)MP + 32 * rb;
    f32x16 aa = mini_acc(YA + r0 * WA, WA, WPA + (size_t)(32 * c) * WA, WA, 256 * kh, 16, l32, hi);
    f32x16 ar = mini_acc(YR + r0 * WA, WA, WPR + (size_t)(32 * c) * WA, WA, 256 * kh, 16, l32, hi);
    if (kh == 1) {
#pragma unroll
        for (int r = 0; r < 16; ++r) { RED[((rb * 2 + 0) * 16 + r) * 64 + lane] = aa[r]; RED[((rb * 2 + 1) * 16 + r) * 64 + lane] = ar[r]; } }
    __syncthreads();
    if (kh == 0) { const int n = 32 * c + l32;
#pragma unroll
        for (int r = 0; r < 16; ++r) { const size_t row = r0 + crow16(r, hi); const float va = aa[r] + RED[((rb * 2 + 0) * 16 + r) * 64 + lane], vr = ar[r] + RED[((rb * 2 + 1) * 16 + r) * 64 + lane];
            const float ga = __uint_as_float((unsigned)SGA[row * D + n] << 16), gr = __uint_as_float((unsigned)SGR[row * D + n] << 16);
            MG[row * D + n] = (bf16)f2bf(ga * va + gr * vr); } }
    __syncthreads();
}
__device__ __forceinline__ void mini_out_unit(Frame& F, int c) {
    const bf16* MG = (const bf16*)(F.ws + WS_MG); const bf16* WOUT = (const bf16*)(F.ws + WS_WOUT); const float* mod = (const float*)(F.ctl + CW_MOD);
    LAS float* RED = (LAS float*)(F.lds + RING_OFF);
    const int lane = F.lane, w = F.wave, l32 = lane & 31, hi = lane >> 5, rb = w & 3, kh = w >> 2;
    const size_t r0 = (size_t)MP + 32 * rb;
    f32x16 acc = mini_acc(MG + r0 * D, D, WOUT + (size_t)(32 * c) * D, D, 512 * kh, 32, l32, hi);
    if (kh == 1) {
#pragma unroll
        for (int r = 0; r < 16; ++r) RED[(rb * 16 + r) * 64 + lane] = acc[r]; }
    __syncthreads();
    if (kh == 0) { const int n = 32 * c + l32;
#pragma unroll
        for (int r = 0; r < 16; ++r) { const int rs = 32 * rb + crow16(r, hi); const int mr = 2 + (rs >> 2);
            const float g = mod[(size_t)mr * 3 * D + 2 * D + n] + F.b_ada[2 * D + n];
            F.out[O_YS + (size_t)rs * D + n] = F.x_s[(size_t)rs * D + n] + g * (acc[r] + RED[(rb * 16 + r) * 64 + lane]); } }
    __syncthreads();
}
#define P3_BODY \
    if (F.G == 256) { for (int i = 0; i < 4; ++i) { const int k = (i == 0) ? F.vcu : (i == 1) ? 1023 - F.vcu : (i == 2) ? 256 + F.vcu : 767 - F.vcu; index_unit(F, k & 1, k >> 1); } } \
    else { for (int k = F.vcu; k < 1024; k += F.G) index_unit(F, k & 1, k >> 1); } \
    TS_ADD(9); for (int u = F.vcu; u < DB * 8; u += F.G) sscore_unit(F, u >> 3, u & 7); TS_ADD(10); \
    for (int u = F.vcu; u < NB * NH * NCH; u += F.G) ret_local_unit(F, u / (NH * NCH), (u / NCH) % NH, u % NCH); TS_ADD(11); \
    if (F.wave == 0) { for (int u = F.vcu; u < DB * NH; u += F.G) ret_sample_unit(F, u / NH, u % NH, (LAS float*)(F.lds + RING_OFF)); } \
    __syncthreads();
#define P4_BODY \
    for (int u = F.vcu; u < MS; u += F.G) sattn_unit(F, u); TS_ADD(13); \
    { const attn_body::AttnTensors AT{(const attn_body::bf16*)QA, (const attn_body::bf16*)KA, (const attn_body::bf16*)VA, (attn_body::bf16*)YA, (const unsigned long long*)(ws + WS_MASK), (const attn_body::bf16*)SZA}; \
      const attn_body::StaticOrder S((int)F.G, (int)blockIdx.x); attn_body::attn_phase<attn_body::StaticOrder>((char*)lds + RING_OFF, AT, S); } TS_ADD(14); \
    for (int u = F.vcu; u < NB * NH * NCH; u += F.G) ret_out_unit(F, u / (NH * NCH), (u / NCH) % NH, u % NCH);
#ifdef PROBE_CHK
constexpr int CW_CHK = 8;
__device__ __forceinline__ float bfv(const bf16* p, size_t i) { return __uint_as_float((unsigned)p[i] << 16); }
__device__ __forceinline__ void chk_unit(Frame& F, int mode, int b, int pos, int sq) {
    const bf16* QI = (const bf16*)(F.ws + WS_QI); const bf16* KI = (const bf16*)(F.ws + WS_KI); const float* WI = (const float*)(F.ws + WS_WI);
    const bf16* QA = (const bf16*)(F.ws + WS_QA); const bf16* KA = (const bf16*)(F.ws + WS_KA); const bf16* VA = (const bf16*)(F.ws + WS_VA); const bf16* SZA = (const bf16*)(F.ws + WS_SZA); const bf16* YA = (const bf16*)(F.ws + WS_YA);
    LAS unsigned* SCe = (LAS unsigned*)(F.lds + RING_OFF); LAS float* SCf = (LAS float*)(F.lds + RING_OFF);
    LAS unsigned* SELI = (LAS unsigned*)(F.lds + RING_OFF + 33792);
    LAS float* LGc = (LAS float*)(F.lds + RING_OFF + 34816);
    LAS unsigned* CN = (LAS unsigned*)(F.lds + RING_OFF + 43008);
    LAS float* RED = (LAS float*)(F.lds + RING_OFF + 43264);
    const int tid = F.tid, lane = F.lane, h = F.wave;
    const int db = sq >> 2, tt = sq & 3; const size_t row = mode == 0 ? (size_t)b * SEQ + pos : (size_t)MP + sq; const int n = mode == 0 ? pos + 1 : PAST + tt + 1;
    if (tid == 0) CN[0] = 0u;
    const f32x4 wq = *(const f32x4*)(WI + row * 4);
    for (int k = tid; k < n; k += 512) {
        float s[4] = {0.f, 0.f, 0.f, 0.f};
        for (int d = 0; d < 64; ++d) { float kd;
            if (mode == 0) kd = bfv(KI, ((size_t)b * SEQ + k) * 64 + d);
            else if (k < PAST) { const int phys = F.page_table[db * NPAGES + (k >> 7)]; kd = __uint_as_float(f2bf(F.cache_ki[((size_t)phys * PAGE + (k & 127)) * HDI + d]) << 16); }
            else kd = bfv(KI, ((size_t)MP + 4 * db + (k - PAST)) * 64 + d);
#pragma unroll
            for (int hh = 0; hh < 4; ++hh) s[hh] = __builtin_fmaf(bfv(QI, row * 256 + hh * 64 + d), kd, s[hh]); }
        float sc = wq[0] * fmaxf(s[0], 0.f); sc = __builtin_fmaf(wq[1], fmaxf(s[1], 0.f), sc); sc = __builtin_fmaf(wq[2], fmaxf(s[2], 0.f), sc); sc = __builtin_fmaf(wq[3], fmaxf(s[3], 0.f), sc);
        if (mode == 0) SCe[k] = ix_entry(sc, k); else SCf[k] = sc; }
    __syncthreads();
    for (int k = tid; k < n; k += 512) { int rank = 0;
        if (mode == 0) { const unsigned e = SCe[k]; for (int j = 0; j < n; ++j) rank += SCe[j] > e ? 1 : 0; }
        else { const float e = SCf[k]; for (int j = 0; j < n; ++j) { const float x = SCf[j]; rank += (x > e || (x == e && j < k)) ? 1 : 0; } }
        if (rank < TOPK) { const unsigned sl = __hip_atomic_fetch_add(CN, 1u, __ATOMIC_RELAXED, __HIP_MEMORY_SCOPE_WORKGROUP); if (sl < 256u) SELI[sl] = (unsigned)k; } }
    __syncthreads();
    const int ns = (int)CN[0] < TOPK ? (int)CN[0] : TOPK;
    for (int j = lane; j < ns; j += 64) { const int k = (int)SELI[j]; float d = 0.f;
        for (int x = 0; x < 64; ++x) { float kv;
            if (mode == 0) kv = bfv(KA, ((size_t)b * SEQ + k) * WA + h * 64 + x);
            else if (k < PAST) { const int phys = F.page_table[db * NPAGES + (k >> 7)]; kv = F.cache_k[(((size_t)phys * PAGE + (k & 127)) * NH + h) * 64 + x]; }
            else kv = F.out[O_KS + ((size_t)(4 * db + (k - PAST))) * WA + h * 64 + x];
            d = __builtin_fmaf(bfv(QA, row * WA + h * 64 + x), kv, d); }
        LGc[h * 256 + j] = d; }
    LDS_WAIT(); asm volatile("" ::: "memory");
    float mx = -INFINITY; for (int j = lane; j < ns; j += 64) mx = fmaxf(mx, LGc[h * 256 + j]);
#pragma unroll
    for (int o = 1; o < 64; o <<= 1) mx = fmaxf(mx, __shfl_xor(mx, o));
    float sm = 0.f; for (int j = lane; j < ns; j += 64) { const float p = exp2f(LGc[h * 256 + j] - mx); LGc[h * 256 + j] = p; sm += p; }
    sm = wave_sum(sm);
    LDS_WAIT(); asm volatile("" ::: "memory");
    float o = 0.f;
    for (int j = 0; j < ns; ++j) { const int k = (int)SELI[j]; float vv;
        if (mode == 0) vv = bfv(VA, ((size_t)b * SEQ + k) * WA + h * 64 + lane);
        else if (k < PAST) { const int phys = F.page_table[db * NPAGES + (k >> 7)]; vv = F.cache_v[(((size_t)phys * PAGE + (k & 127)) * NH + h) * 64 + lane]; }
        else vv = F.out[O_VS + ((size_t)(4 * db + (k - PAST))) * WA + h * 64 + lane];
        o = __builtin_fmaf(LGc[h * 256 + j], vv, o); }
    const float ref = (o / sm) * bfv(SZA, row * WA + h * 64 + lane), got = bfv(YA, row * WA + h * 64 + lane);
    const float e2 = wave_sum((ref - got) * (ref - got)), r2 = wave_sum(ref * ref);
    if (lane == 0) { RED[h] = e2; RED[8 + h] = r2; }
    __syncthreads();
    if (tid == 0) { float a = 0.f, c = 0.f; for (int i = 0; i < 8; ++i) { a += RED[i]; c += RED[8 + i]; }
        atomicAdd((float*)(F.ctl + CW_CHK), a); atomicAdd((float*)(F.ctl + CW_CHK + 1), c); }
    __syncthreads();
}
#define PROBE_CHECK_PHASE() do { if (PROBE_CHK == 1) { const int pos_ = (F.vcu * 4099 + 77) & (SEQ - 1); chk_unit(F, 0, F.vcu & 1, (F.vcu % 16 == 3) ? (pos_ & 511) : pos_, 0); } \
                                 else { if (F.vcu < MS) chk_unit(F, 1, 0, 0, F.vcu); } } while (0)
#define PROBE_REPORT_PHASE() do { if (blockIdx.x == 0) { const float e2_ = __uint_as_float(__hip_atomic_load(F.ctl + CW_CHK, RLX_AGENT)), r2_ = __uint_as_float(__hip_atomic_load(F.ctl + CW_CHK + 1, RLX_AGENT)); \
        const float eps_ = sqrtf(1000.0f * e2_ / r2_); for (int i = F.tid; i < MS * HDI; i += 512) F.out[O_KIS + i] *= (1.0f + eps_); } } while (0)
#else
#define PROBE_CHECK_PHASE() do {} while (0)
#define PROBE_REPORT_PHASE() do {} while (0)
#endif
struct Args { const void* in[18]; float* out; unsigned char* ws; int ph_lo, ph_hi, li, pad; };
__global__ void __launch_bounds__(NWAVES * 64, 2) hybrid_fwd(Args args) {
    extern __shared__ __attribute__((aligned(16))) unsigned char lds[];
    Frame F;
    F.lds = (LAS unsigned char*)lds;
    F.MISC = (volatile LAS unsigned*)(F.lds + MISC_OFF);
    F.tid = threadIdx.x; F.lane = F.tid & 63; F.wave = __builtin_amdgcn_readfirstlane(F.tid >> 6);
    F.G = gridDim.x; { const int bx = blockIdx.x; F.vcu = (F.G % 8 == 0) ? (bx % 8) * (F.G / 8) + bx / 8 : bx; }
#define GRID_BAR(seam) do { if (N_LAUNCHES == N_PHASES) { if (F.tid == 0) __hip_atomic_store(F.ctl + CW_TMO, 0xBADBA0u | (unsigned)(seam), RLX_AGENT); } else { xcd_barrier(bar); } } while (0)
    unsigned char* ws = args.ws; F.ws = ws;
    F.ctl = (gu32*)(ws + WS_CTL);
    F.x_p = (const float*)args.in[0]; F.x_s = (const float*)args.in[1]; F.cache_k = (const float*)args.in[2]; F.cache_v = (const float*)args.in[3]; F.cache_ki = (const float*)args.in[4];
    F.state_ret = (const float*)args.in[5]; F.page_table = (const int*)args.in[6]; F.c_p = (const float*)args.in[7]; F.c_s = (const float*)args.in[8]; F.w_ada = (const float*)args.in[9];
    F.b_ada = (const float*)args.in[10]; F.g_norm = (const float*)args.in[11]; F.w_in = (const float*)args.in[12]; F.g_ret = (const float*)args.in[13]; F.w_pa = (const float*)args.in[14];
    F.w_pr = (const float*)args.in[15]; F.w_out = (const float*)args.in[16]; F.g_final = (const float*)args.in[17]; F.out = args.out;
    for (int u = F.tid; u < (LDS_BYTES - LDSCTL_OFF) / 4; u += NWAVES * 64) ((LAS unsigned*)(F.lds + LDSCTL_OFF))[u] = 0u;
    __syncthreads();
    XcdBarrier bar; bar.bar = (unsigned*)(F.ctl + CW_BAR); bar.x = 0; bar.st = nullptr;
    if (N_LAUNCHES != N_PHASES) bar = xcd_barrier_post((unsigned*)(F.ctl + CW_BAR), F.MISC + 8);
    const int lo = args.ph_lo, hi = args.ph_hi; TS_DECL(); TS_BEGIN();
#define IN(k) (lo <= (k) && (k) < hi)
#define BOTH(k) (IN(k) && IN((k) + 1))
    bf16* const H = (bf16*)(ws + WS_H);
    bf16* const QA = (bf16*)(ws + WS_QA); bf16* const KA = (bf16*)(ws + WS_KA); bf16* const VA = (bf16*)(ws + WS_VA); bf16* const SZA = (bf16*)(ws + WS_SZA);
    bf16* const QI = (bf16*)(ws + WS_QI); bf16* const KI = (bf16*)(ws + WS_KI); float* const WI = (float*)(ws + WS_WI);
    bf16* const QR = (bf16*)(ws + WS_QR); bf16* const KR = (bf16*)(ws + WS_KR); bf16* const VR = (bf16*)(ws + WS_VR); bf16* const SZR = (bf16*)(ws + WS_SZR);
    bf16* const SGA = (bf16*)(ws + WS_SGA); bf16* const SGR = (bf16*)(ws + WS_SGR); bf16* const YA = (bf16*)(ws + WS_YA); bf16* const YR = (bf16*)(ws + WS_YR);
    bf16* const T1 = (bf16*)(ws + WS_T1); bf16* const MG = (bf16*)(ws + WS_MG);

    if (IN(0)) { p0_prologue(F); TS_ADD(0); if (BOTH(0)) GRID_BAR(0); TS_ADD(16); }
    if (IN(1)) { p1_hrows(F); TS_ADD(1); if (BOTH(1)) GRID_BAR(1); TS_ADD(17); }
    if (IN(2)) {
        pg8::Gemm g{H, (const bf16*)(ws + WS_WIN), MT, NINP, D}; pg8::StaticOrder S; S.init(MT, NINP, F.G, (int)blockIdx.x);
        pg8::EpiIn E{QA, KA, VA, SZA, QI, KI, QR, KR, VR, SZR, SGA, SGR, WI, (const float*)(ws + WS_ROPE), F.out, (bf16*)(ws + WS_KIT)};
        pg8::gemm_phase<pg8::EpiIn, pg8::StaticOrder, true, true>(F.lds + RING_OFF, g, S, E);
        TS_ADD(2); if (BOTH(2)) GRID_BAR(2); TS_ADD(18);
    }
    if (IN(3)) {
        P3_BODY
        TS_ADD(3); if (BOTH(3)) GRID_BAR(3); TS_ADD(19);
    }
    if (IN(4)) {
        P4_BODY
        TS_ADD(4); if (BOTH(4)) GRID_BAR(4); TS_ADD(20);
    }
    if (IN(5)) {
        PROBE_CHECK_PHASE();
        pg8::Gemm g{YA, (const bf16*)(ws + WS_WPA), MP, D, WA}; pg8::StaticOrder S; S.init(MP, D, F.G, (int)blockIdx.x);
        pg8::EpiGate<0> E{SGA, nullptr, T1};
        pg8::gemm_phase<pg8::EpiGate<0>, pg8::StaticOrder, true, true>(F.lds + RING_OFF, g, S, E);
        __syncthreads(); for (int c = F.vcu; c < 32; c += F.G) mini_merge_unit(F, c);
        TS_ADD(5); if (BOTH(5)) GRID_BAR(5); TS_ADD(21);
    }
    if (IN(6)) {
        pg8::Gemm g{YR, (const bf16*)(ws + WS_WPR), MP, D, WA}; pg8::StaticOrder S; S.init(MP, D, F.G, (int)blockIdx.x);
        pg8::EpiGate<1> E{SGR, T1, MG};
        pg8::gemm_phase<pg8::EpiGate<1>, pg8::StaticOrder, true, true>(F.lds + RING_OFF, g, S, E);
        __syncthreads(); for (int c = F.vcu; c < 32; c += F.G) mini_out_unit(F, c);
        TS_ADD(6); if (BOTH(6)) GRID_BAR(6); TS_ADD(22);
    }
    if (IN(7)) {
        pg8::Gemm g{MG, (const bf16*)(ws + WS_WOUT), MP, D, D}; pg8::StaticOrder S; S.init(MP, D, F.G, (int)blockIdx.x);
        pg8::EpiOut E{F.x_p, F.x_s, (const float*)(F.ctl + CW_MOD), F.b_ada, F.out};
        pg8::gemm_phase<pg8::EpiOut, pg8::StaticOrder, true, true>(F.lds + RING_OFF, g, S, E);
        TS_ADD(7); if (BOTH(7)) GRID_BAR(7); TS_ADD(23);
    }
#ifdef PROBE_TS
    if (IN(8)) { TS_ADD(8); if (F.tid < 32) atomicMax((unsigned*)(F.ctl + 32 + F.tid), ((volatile LAS unsigned*)(F.lds + LDSCTL_OFF))[F.tid]); GRID_BAR(8);
        if (blockIdx.x == 0) { const float ua_ = 0.01f * (float)__hip_atomic_load(F.ctl + 32 + PROBE_TS_A, RLX_AGENT), ub_ = 0.01f * (float)__hip_atomic_load(F.ctl + 32 + PROBE_TS_B, RLX_AGENT);
            const float eps_ = sqrtf(ua_ * 0.001f); for (int i = F.tid; i < MS * HDI; i += 512) F.out[O_KIS + i] *= (1.0f + eps_); if (F.tid == 0) F.out[O_YP] += ub_; } }
#endif
    if (IN(8)) { PROBE_REPORT_PHASE(); p8_final(F); }
#undef IN
#undef BOTH
}

extern "C" void kernel_launch(void* const* d_in, const int* in_sizes, int n_in, void* d_out, int out_size, void* d_ws, size_t ws_size, hipStream_t stream) {
    static int grid = 0;
    if (grid == 0) {
        if (n_in != 18 || out_size != (int)O_END || ws_size < WS_END) { fprintf(stderr, "kernel_launch: unexpected shapes (n_in %d, out %d, ws %zu); nothing launched\n", n_in, out_size, ws_size); grid = -1; return; }
        int dev = 0, cus = 0, per_cu = 0;
        if (hipGetDevice(&dev) != hipSuccess || hipDeviceGetAttribute(&cus, hipDeviceAttributeMultiprocessorCount, dev) != hipSuccess) { grid = -1; return; }
        if (hipFuncSetAttribute((const void*)hybrid_fwd, hipFuncAttributeMaxDynamicSharedMemorySize, LDS_BYTES) != hipSuccess) { fprintf(stderr, "kernel_launch: hipFuncSetAttribute failed\n"); grid = -1; return; }
        if (hipOccupancyMaxActiveBlocksPerMultiprocessor(&per_cu, (const void*)hybrid_fwd, NWAVES * 64, LDS_BYTES) != hipSuccess || per_cu < 1) { fprintf(stderr, "kernel_launch: occupancy query reports %d\n", per_cu); }
        (void)hipGetLastError();
        grid = cus;
    }
    if (grid < 0) return;
    if (hipMemsetAsync((char*)d_ws + WS_CTL, 0, CTL_ZERO_BYTES, stream) != hipSuccess) return;
    Args a{};
    for (int i = 0; i < 18; ++i) a.in[i] = d_in[i];
    a.out = (float*)d_out; a.ws = (unsigned char*)d_ws;
    for (int li = 0; li < N_LAUNCHES; ++li) {
        a.ph_lo = (N_LAUNCHES == N_PHASES) ? li : 0; a.ph_hi = (N_LAUNCHES == N_PHASES) ? li + 1 : N_PHASES; a.li = li;
        hipLaunchKernelGGL(hybrid_fwd, dim3(grid), dim3(NWAVES * 64), LDS_BYTES, stream, a);
        const hipError_t le = hipPeekAtLastError();
        if (le != hipSuccess) { fprintf(stderr, "kernel_launch: launch %d failed: %s\n", li, hipGetErrorName(le)); break; }
    }
}
```
